# Optimizing an MI355X kernel written in HIP

```python
import math
import jax, jax.numpy as jnp
from jax import lax
import numpy as np

D_MODEL = 1024
BATCH = 4
SEQ = 4096
DEPTH = 2

N_A_LAYERS = DEPTH // 2
N_B_LAYERS = DEPTH - N_A_LAYERS
EPS = 1e-6

EXPAND = 2
CONV_D = EXPAND * D_MODEL
CONV_WIDTH = 3

N_HEADS = 16
HEAD_DIM = D_MODEL // N_HEADS
N_KV_GROUPS = 4
HEADS_PER_GROUP = N_HEADS // N_KV_GROUPS
ATTN_D = N_HEADS * HEAD_DIM
KV_D = N_KV_GROUPS * HEAD_DIM
N_BRANCH = 3
N_KV_STREAMS = 6
ROT_DIM = HEAD_DIM // 4
ROPE_THETA = 500000.0
CMP_BLOCK = 32
CMP_STRIDE = 16
CMP_R = CMP_BLOCK // CMP_STRIDE
CMP_HIDDEN = 4 * HEAD_DIM
SLC_BLOCK = 64
SLC_RATIO = SLC_BLOCK // CMP_STRIDE
N_SELECT = 16
N_LOCAL = 2
WINDOW = 512
Q_BLOCK = 64
FORCE_SCORE = 1e4

kernel_name = "yoco_shortconv_nsa_hybrid"


def rmsnorm(x, g):
    xf = x.astype(jnp.float32)
    y = xf * lax.rsqrt(jnp.mean(xf * xf, axis=-1, keepdims=True) + EPS)
    return (y * g.astype(jnp.float32)).astype(x.dtype)


def partial_rope(x):
    S = x.shape[1]
    pos = jnp.arange(S, dtype=jnp.float32)
    inv = ROPE_THETA ** (-jnp.arange(0, ROT_DIM, 2, dtype=jnp.float32) / ROT_DIM)
    ang = pos[:, None] * inv[None, :]
    cos = jnp.cos(ang)[None, :, None, :]
    sin = jnp.sin(ang)[None, :, None, :]
    xr = x[..., :ROT_DIM].astype(jnp.float32)
    x1, x2 = xr[..., :ROT_DIM // 2], xr[..., ROT_DIM // 2:]
    rot = jnp.concatenate([x1 * cos - x2 * sin, x2 * cos + x1 * sin], axis=-1).astype(x.dtype)
    return jnp.concatenate([rot, x[..., ROT_DIM:]], axis=-1)


def masked_softmax(s, mask, axis=-1):
    s = jnp.where(mask, s.astype(jnp.float32), -jnp.inf)
    m = jnp.max(s, axis=axis, keepdims=True)
    m = jnp.where(jnp.isfinite(m), m, 0.0)
    e = jnp.where(mask, jnp.exp(s - m), 0.0)
    d = jnp.sum(e, axis=axis, keepdims=True)
    return e / jnp.maximum(d, 1e-30)


def short_conv_layer(x, norm_g, w_in, conv_w, w_out):
    S = x.shape[1]
    h = rmsnorm(x, norm_g)
    proj = h @ w_in
    b, c, u, z = jnp.split(proj, 4, axis=-1)
    vp = jnp.pad(c * u, ((0, 0), (CONV_WIDTH - 1, 0), (0, 0)))
    conv = conv_w[0] * vp[:, 0:S]
    for k in range(1, CONV_WIDTH):
        conv = conv + conv_w[k] * vp[:, k:k + S]
    y = b * conv * jax.nn.silu(z)
    return x + y @ w_out


def compress_blocks(kv, pos_emb, w1, w2):
    B, S, G, D = kv.shape
    chunks = kv.reshape(B, S // CMP_STRIDE, CMP_STRIDE, G, D)
    n_cmp = S // CMP_STRIDE - CMP_R + 1
    blocks = jnp.concatenate([chunks[:, r:r + n_cmp] for r in range(CMP_R)], axis=2)
    blocks = blocks + pos_emb[None, None, :, None, :]
    flat = blocks.transpose(0, 1, 3, 2, 4).reshape(B, n_cmp, G, CMP_BLOCK * D)
    return jax.nn.gelu(flat @ w1) @ w2


def shared_kv(h, norm_g, w_kv, cmp_pos_k, cmp_w1_k, cmp_w2_k, cmp_pos_v, cmp_w1_v, cmp_w2_v):
    B, S, _ = h.shape
    kv = (rmsnorm(h, norm_g) @ w_kv).reshape(B, S, N_KV_STREAMS, N_KV_GROUPS, HEAD_DIM)
    k_c, v_c, k_s, v_s, k_w, v_w = [kv[:, :, i] for i in range(N_KV_STREAMS)]
    k_cmp = compress_blocks(k_c, cmp_pos_k, cmp_w1_k, cmp_w2_k)
    v_cmp = compress_blocks(v_c, cmp_pos_v, cmp_w1_v, cmp_w2_v)
    return (k_cmp, v_cmp, partial_rope(k_s), v_s, partial_rope(k_w), v_w)


def nsa_attention(q, q_rot, gates, k_cmp, v_cmp, k_slc, v_slc, k_win, v_win):
    B, S, H, D = q.shape
    G, I = N_KV_GROUPS, HEADS_PER_GROUP
    n_blk = S // Q_BLOCK
    n_cmp = k_cmp.shape[1]
    n_sb = S // SLC_BLOCK
    n_sel = min(N_SELECT, n_sb)
    scale = HEAD_DIM ** -0.5
    cmp_end = jnp.arange(n_cmp) * CMP_STRIDE + CMP_BLOCK - 1
    kb_slc = k_slc.reshape(B, n_sb, SLC_BLOCK, G, D).transpose(0, 3, 1, 2, 4)
    vb_slc = v_slc.reshape(B, n_sb, SLC_BLOCK, G, D).transpose(0, 3, 1, 2, 4)
    k_win_p = jnp.pad(k_win, ((0, 0), (WINDOW, 0), (0, 0), (0, 0)))
    v_win_p = jnp.pad(v_win, ((0, 0), (WINDOW, 0), (0, 0), (0, 0)))
    bi = jnp.arange(B)[:, None, None, None]
    gi = jnp.arange(G)[None, None, :, None]
    blk_ids = jnp.arange(n_sb)

    def to_blocks(a):
        return a.reshape(B, n_blk, Q_BLOCK, G, I, a.shape[-1]).transpose(1, 0, 2, 3, 4, 5)

    def block_fn(args):
        blk, qc, qr, g = args
        start = blk * Q_BLOCK
        t = start + jnp.arange(Q_BLOCK)

        s_c = jnp.einsum('bqgid,bngd->bqgin', qc, k_cmp) * scale
        m_c = (cmp_end[None, :] <= t[:, None])[None, :, None, None, :]
        p_c = masked_softmax(s_c, m_c)
        o_c = jnp.einsum('bqgin,bngd->bqgid', p_c.astype(v_cmp.dtype), v_cmp)

        p_grp = jnp.pad(p_c.sum(axis=3), ((0, 0), (0, 0), (0, 0), (CMP_R - 1, CMP_R - 1)))
        imp = 0.0
        for m in range(SLC_RATIO):
            for n in range(CMP_R):
                off = CMP_R - 1 + m - n
                imp = imp + p_grp[..., off:off + SLC_RATIO * (n_sb - 1) + 1:SLC_RATIO]
        cur = t // SLC_BLOCK
        valid = blk_ids[None, :] <= cur[:, None]
        forced = (blk_ids[None, :] == 0) | (valid & (blk_ids[None, :] > cur[:, None] - N_LOCAL))
        score = jnp.where(forced[None, :, None, :], FORCE_SCORE, imp)
        score = jnp.where(valid[None, :, None, :], score, -jnp.inf)
        top_s, idx = lax.top_k(score, n_sel)
        sel_ok = jnp.isfinite(top_s)

        kg = kb_slc[bi, gi, idx]
        vg = vb_slc[bi, gi, idx]
        s_s = jnp.einsum('bqgid,bqgnld->bqginl', qr, kg) * scale
        kpos = idx[..., None] * SLC_BLOCK + jnp.arange(SLC_BLOCK)
        m_s = sel_ok[..., None] & (kpos <= t[None, :, None, None, None])
        p_s = masked_softmax(s_s.reshape(B, Q_BLOCK, G, I, n_sel * SLC_BLOCK),
                             m_s.reshape(B, Q_BLOCK, G, 1, n_sel * SLC_BLOCK))
        p_s = p_s.reshape(B, Q_BLOCK, G, I, n_sel, SLC_BLOCK).astype(vg.dtype)
        o_s = jnp.einsum('bqginl,bqgnld->bqgid', p_s, vg)

        kw = lax.dynamic_slice_in_dim(k_win_p, start, WINDOW + Q_BLOCK, axis=1)
        vw = lax.dynamic_slice_in_dim(v_win_p, start, WINDOW + Q_BLOCK, axis=1)
        kpos_w = start - WINDOW + jnp.arange(WINDOW + Q_BLOCK)
        m_w = ((kpos_w[None, :] <= t[:, None]) & (kpos_w[None, :] > t[:, None] - WINDOW)
               & (kpos_w[None, :] >= 0))
        s_w = jnp.einsum('bqgid,bkgd->bqgik', qr, kw) * scale
        p_w = masked_softmax(s_w, m_w[None, :, None, None, :]).astype(vw.dtype)
        o_w = jnp.einsum('bqgik,bkgd->bqgid', p_w, vw)

        return g[..., 0:1] * o_c + g[..., 1:2] * o_s + g[..., 2:3] * o_w

    xs = (jnp.arange(n_blk), to_blocks(q), to_blocks(q_rot), to_blocks(gates))
    out = lax.map(block_fn, xs)
    return out.transpose(1, 0, 2, 3, 4, 5).reshape(B, S, H, D)


def nsa_layer(x, kvs, norm_g, w_in, w_out):
    B, S, _ = x.shape
    h = rmsnorm(x, norm_g)
    proj = h @ w_in
    q = proj[..., :ATTN_D].reshape(B, S, N_HEADS, HEAD_DIM)
    gates = jax.nn.sigmoid(proj[..., ATTN_D:ATTN_D + N_HEADS * N_BRANCH]
                           .reshape(B, S, N_HEADS, N_BRANCH))
    z = proj[..., ATTN_D + N_HEADS * N_BRANCH:]
    o = nsa_attention(q, partial_rope(q), gates, *kvs)
    y = o.reshape(B, S, ATTN_D) * jax.nn.silu(z)
    return x + y @ w_out


def setup_inputs(seed: int = 0) -> dict:
    key = jax.random.key(seed)
    ks = jax.random.split(key, 20)
    f = jnp.float32
    nrm = lambda k, shape, s: jax.random.normal(k, shape, f) * s
    gain = lambda k, shape: 1.0 + 0.01 * jax.random.normal(k, shape, f)
    b_in_cols = ATTN_D + N_HEADS * N_BRANCH + ATTN_D
    return {
        "x": jax.random.normal(ks[0], (BATCH, SEQ, D_MODEL), f),
        "a_norm": gain(ks[1], (N_A_LAYERS, D_MODEL)),
        "a_w_in": nrm(ks[2], (N_A_LAYERS, D_MODEL, 4 * CONV_D), D_MODEL ** -0.5),
        "a_conv_w": nrm(ks[3], (N_A_LAYERS, CONV_WIDTH, CONV_D), CONV_WIDTH ** -0.5),
        "a_w_out": nrm(ks[4], (N_A_LAYERS, CONV_D, D_MODEL), CONV_D ** -0.5),
        "kv_norm": gain(ks[5], (D_MODEL,)),
        "w_kv": nrm(ks[6], (D_MODEL, N_KV_STREAMS * KV_D), D_MODEL ** -0.5),
        "cmp_pos_k": nrm(ks[7], (CMP_BLOCK, HEAD_DIM), 0.1),
        "cmp_w1_k": nrm(ks[8], (CMP_BLOCK * HEAD_DIM, CMP_HIDDEN), (CMP_BLOCK * HEAD_DIM) ** -0.5),
        "cmp_w2_k": nrm(ks[9], (CMP_HIDDEN, HEAD_DIM), CMP_HIDDEN ** -0.5),
        "cmp_pos_v": nrm(ks[10], (CMP_BLOCK, HEAD_DIM), 0.1),
        "cmp_w1_v": nrm(ks[11], (CMP_BLOCK * HEAD_DIM, CMP_HIDDEN), (CMP_BLOCK * HEAD_DIM) ** -0.5),
        "cmp_w2_v": nrm(ks[12], (CMP_HIDDEN, HEAD_DIM), CMP_HIDDEN ** -0.5),
        "b_norm": gain(ks[13], (N_B_LAYERS, D_MODEL)),
        "b_w_in": nrm(ks[14], (N_B_LAYERS, D_MODEL, b_in_cols), D_MODEL ** -0.5),
        "b_w_out": nrm(ks[15], (N_B_LAYERS, ATTN_D, D_MODEL), ATTN_D ** -0.5),
        "final_norm": gain(ks[16], (D_MODEL,)),
    }


def reference(x, a_norm, a_w_in, a_conv_w, a_w_out, kv_norm, w_kv, cmp_pos_k, cmp_w1_k,
              cmp_w2_k, cmp_pos_v, cmp_w1_v, cmp_w2_v, b_norm, b_w_in, b_w_out, final_norm):
    h = x
    kvs = None
    for layer in range(DEPTH):
        if layer < N_A_LAYERS:
            h = short_conv_layer(h, a_norm[layer], a_w_in[layer], a_conv_w[layer], a_w_out[layer])
        else:
            if layer == N_A_LAYERS:
                kvs = shared_kv(h, kv_norm, w_kv, cmp_pos_k, cmp_w1_k, cmp_w2_k,
                                cmp_pos_v, cmp_w1_v, cmp_w2_v)
            j = layer - N_A_LAYERS
            h = nsa_layer(h, kvs, b_norm[j], b_w_in[j], b_w_out[j])
    return rmsnorm(h, final_norm)
```

```cpp
#include <hip/hip_runtime.h>
#include <cstdio>
#include <cstdint>
#include <cmath>

#define LAS __attribute__((address_space(3)))
#define GAS __attribute__((address_space(1)))
typedef unsigned short h16_t;
typedef short h16x8 __attribute__((ext_vector_type(8)));
typedef float f32x4 __attribute__((ext_vector_type(4)));
typedef float f32x16 __attribute__((ext_vector_type(16)));
typedef unsigned u32x4 __attribute__((ext_vector_type(4)));
typedef unsigned u32x2 __attribute__((ext_vector_type(2)));

constexpr int D_MODEL = 1024, BATCH = 4, SEQ = 4096, M_ROWS = BATCH * SEQ;
constexpr int CONV_D = 2048, N_HEADS = 16, HEAD_DIM = 64, N_GROUPS = 4;
constexpr int N3 = 3840;
constexpr float EPS = 1e-6f;
constexpr int NWAVES = 8, NTHREADS = 512;
constexpr int N_PHASES = 9;

constexpr size_t MiB = 1u << 20;
constexpr size_t WS_CTL = 0, CTL_ZERO_BYTES = 1 * MiB;
constexpr size_t WS_ROPE = 1 * MiB;
constexpr size_t WS_SS1 = 1 * MiB + 512 * 1024;
constexpr size_t WS_SS2 = 2 * MiB + 512 * 1024;
constexpr size_t WS_CBP = 3 * MiB + 512 * 1024;
constexpr size_t WS_KCMP = 4 * MiB;
constexpr size_t WS_VCMP = 4 * MiB + 512 * 1024;
constexpr size_t WS_W1T = 8 * MiB;
constexpr size_t WS_W2T = 24 * MiB;
constexpr size_t WS_W3T = 28 * MiB;
constexpr size_t WS_W4T = 36 * MiB;
constexpr size_t WS_CW1K = 38 * MiB, WS_CW1V = 39 * MiB;
constexpr size_t WS_CW2K = 40 * MiB, WS_CW2V = 40 * MiB + 512 * 1024;
constexpr size_t WS_XN = 42 * MiB;
constexpr size_t WS_CU = 74 * MiB;
constexpr size_t WS_Q = 74 * MiB, WS_SZ = 106 * MiB;
constexpr size_t WS_BSZ = 138 * MiB;
constexpr size_t WS_KV = 138 * MiB, WS_GATES = 186 * MiB;
constexpr size_t WS_QROT = 202 * MiB;
constexpr size_t WS_END = 234 * MiB;
constexpr int CW_BAR = 4096;

constexpr int RING_BYTES = 131072;
constexpr int LDSCTL_OFF = 144384;
constexpr int LDS_BYTES = 147456;

typedef _Float16 f16x2 __attribute__((ext_vector_type(2)));
typedef _Float16 f16x8 __attribute__((ext_vector_type(8)));
__device__ __forceinline__ unsigned pk2h(float lo, float hi) { f16x2 v; v.x = (_Float16)lo; v.y = (_Float16)hi; return __builtin_bit_cast(unsigned, v); }
__device__ __forceinline__ h16_t f2h(float f) { return __builtin_bit_cast(unsigned short, (_Float16)f); }
__device__ __forceinline__ float h_lo(unsigned w) { return (float)__builtin_bit_cast(f16x2, w).x; }
__device__ __forceinline__ float h_hi(unsigned w) { return (float)__builtin_bit_cast(f16x2, w).y; }
__device__ __forceinline__ float h2f(h16_t h) { return (float)__builtin_bit_cast(_Float16, h); }
#define MFMA16(a, b, c) __builtin_amdgcn_mfma_f32_16x16x32_f16(__builtin_bit_cast(f16x8, a), __builtin_bit_cast(f16x8, b), c, 0, 0, 0)
#define MFMA32(a, b, c) __builtin_amdgcn_mfma_f32_32x32x16_f16(__builtin_bit_cast(f16x8, a), __builtin_bit_cast(f16x8, b), c, 0, 0, 0)
__device__ __forceinline__ float wave_sum(float v) {
#pragma unroll
    for (int o = 1; o < 64; o <<= 1) v += __shfl_xor(v, o);
    return v;
}
__device__ __forceinline__ float wave_max(float v) {
#pragma unroll
    for (int o = 1; o < 64; o <<= 1) v = fmaxf(v, __shfl_xor(v, o));
    return v;
}
__device__ __forceinline__ float silu_f(float z) { return z / (1.0f + __expf(-z)); }
__device__ __forceinline__ float sigmoid_f(float z) { return 1.0f / (1.0f + __expf(-z)); }
__device__ __forceinline__ float gelu_tanh_f(float x) { const float u = 0.7978845608028654f * (x + 0.044715f * x * x * x); return 0.5f * x * (1.0f + tanhf(u)); }

namespace pg8 {
#define PG8_LAS __attribute__((address_space(3)))
constexpr int BM = 256, BK = 64, HALF = 128, HTB = HALF * BK * 2, STAGE_BYTES = 8 * HTB, NXCD = 8, WGM = 8;
__host__ __device__ __forceinline__ int lds_byte(int r, int c) { const int st = (r >> 4) * 2 + (c >> 5), rr = r & 15, cc = c & 31, ob = rr * 64 + cc * 2; return st * 1024 + (ob ^ (((ob >> 9) & 1) << 5)); }
__host__ __device__ __forceinline__ void stage_rc(int b, int& R, int& C) { const int st = b / 1024, sb = b % 1024, swz = sb ^ (((sb >> 9) & 1) << 5); R = (st >> 1) * 16 + swz / 64; C = (st & 1) * 32 + (swz % 64) / 2; }
__host__ __device__ __forceinline__ int perm32(int rho) { const int n = rho >> 4, i = rho & 15; return 8 * (i >> 2) + 4 * n + (i & 3); }
struct Unit { int pm, pn; };
struct Gemm { const h16_t* A; const h16_t* Bt; int M, N, K; };
struct StaticOrder {
    int nM, nN, nwg, G, c;
    __host__ __device__ void init(int M, int N, int G_, int c_) { nM = M / BM; nN = N / BM; nwg = nM * nN; G = G_; c = c_; }
    __host__ __device__ bool next(int i, Unit& u) const {
        const long L = (long)i * G + c; if (L >= nwg) return false;
        int wgid = (int)L; { const int q = nwg / NXCD, r = nwg % NXCD, xcd = wgid % NXCD, off = wgid / NXCD; wgid = (xcd < r ? xcd * (q + 1) : r * (q + 1) + (xcd - r) * q) + off; }
        const int nig = WGM * nN, gid = wgid / nig, fm = gid * WGM, gsz = (nM - fm) < WGM ? (nM - fm) : WGM;
        u.pm = fm + ((wgid % nig) % gsz); u.pn = (wgid % nig) / gsz; return true;
    }
    __device__ __forceinline__ void a_ready(const Unit&) const {}
    __device__ __forceinline__ void done(const Unit&) const {}
};

template <class Epi, class Sched, bool ALIGN_EPI = false, bool SP2 = false>
__device__ __forceinline__ void gemm_phase(PG8_LAS unsigned char* lds, const Gemm g, const Sched& S, const Epi& E) {
    const int tid = threadIdx.x, wid = __builtin_amdgcn_readfirstlane(tid >> 6), lane = tid & 63, wr = wid >> 2, wc = wid & 3, fr = lane & 15, fq = lane >> 4;
    const int K = g.K, nt = K / BK;
    unsigned voffA[2], voffB[2];
#pragma unroll
    for (int i = 0; i < 2; ++i) { int R, C; stage_rc(tid * 16 + i * 8192, R, C); const int Rb = Epi::PERM ? ((R & ~31) + perm32(R & 31)) : R;
        voffA[i] = (unsigned)(R * K + C) * 2u; voffB[i] = (unsigned)(Rb * K + C) * 2u; }
    const size_t kstep = (size_t)(BK * 2);
    const size_t hstep = (size_t)HALF * K * 2;
    const size_t tstep = 2 * hstep;
    const unsigned ldsw = (unsigned)wid * 1024u;
    const int aoff = lds_byte(wr * 64 + fr, fq * 8), boff = lds_byte(wc * 32 + fr, fq * 8);
#define PG8_SA(b, h) (((b) * 2 + (h)) * HTB)
#define PG8_SB(b, h) ((4 + (b) * 2 + (h)) * HTB)
#define PG8_STAGE(bufoff, gbase, voff) do { _Pragma("unroll") for (int _i = 0; _i < 2; ++_i) \
        __builtin_amdgcn_global_load_lds((const unsigned*)((const char*)(gbase) + (voff)[_i]), (PG8_LAS unsigned*)(lds + (bufoff) + ldsw + _i * 8192), 16, 0, 0); } while (0)
#define PG8_LDA(dst, b, h) do { _Pragma("unroll") for (int m = 0; m < 4; ++m) _Pragma("unroll") for (int k = 0; k < 2; ++k) dst[m][k] = *(const PG8_LAS h16x8*)(lds + PG8_SA(b, h) + aoff + m * 2048 + k * 1024); } while (0)
#define PG8_LDB(dst, b, h) do { _Pragma("unroll") for (int n = 0; n < 2; ++n) _Pragma("unroll") for (int k = 0; k < 2; ++k) dst[n][k] = *(const PG8_LAS h16x8*)(lds + PG8_SB(b, h) + boff + n * 2048 + k * 1024); } while (0)
#define PG8_MMA(ai, bj, At, Bt) do { __builtin_amdgcn_s_setprio(1); _Pragma("unroll") for (int m = 0; m < 4; ++m) _Pragma("unroll") for (int n = 0; n < 2; ++n) _Pragma("unroll") for (int k = 0; k < 2; ++k) \
        acc[ai][bj][m][n] = MFMA16(Bt[n][k], At[m][k], acc[ai][bj][m][n]); __builtin_amdgcn_s_setprio(0); } while (0)
#define PG8_WAIT_V(n) asm volatile("s_waitcnt vmcnt(" #n ")" ::: "memory")
#define PG8_WAIT_L(n) asm volatile("s_waitcnt lgkmcnt(" #n ")" ::: "memory")
#define PG8_BAR __builtin_amdgcn_s_barrier()
#define PG8_SCHED __builtin_amdgcn_sched_barrier(0)
    Unit cur, nxt; int ui = 0;
    if (!S.next(0, cur)) return;
    f32x4 acc[2][2][4][2];
#pragma unroll
    for (int a = 0; a < 2; ++a)
#pragma unroll
        for (int b = 0; b < 2; ++b)
#pragma unroll
            for (int m = 0; m < 4; ++m)
#pragma unroll
                for (int n = 0; n < 2; ++n) acc[a][b][m][n] = (f32x4){0.f, 0.f, 0.f, 0.f};
    h16x8 At[4][2], B0[2][2], B1[2][2];
    const char* cA = (const char*)g.A + (size_t)cur.pm * tstep; const char* cB = (const char*)g.Bt + (size_t)cur.pn * tstep;
    S.a_ready(cur);
    if constexpr (SP2) {
        PG8_STAGE(PG8_SB(0, 0), cB, voffB); PG8_STAGE(PG8_SB(0, 1), cB + hstep, voffB); PG8_STAGE(PG8_SA(0, 0), cA, voffA); PG8_STAGE(PG8_SA(0, 1), cA + hstep, voffA);
        if (wr == 1) PG8_BAR;
        PG8_WAIT_V(2); PG8_BAR;
        PG8_STAGE(PG8_SB(1, 0), cB + kstep, voffB); PG8_STAGE(PG8_SA(1, 0), cA + kstep, voffA); PG8_STAGE(PG8_SB(1, 1), cB + hstep + kstep, voffB);
        PG8_WAIT_V(6); PG8_BAR;
    } else {
        PG8_STAGE(PG8_SB(0, 0), cB, voffB); PG8_STAGE(PG8_SA(0, 0), cA, voffA); PG8_STAGE(PG8_SB(0, 1), cB + hstep, voffB); PG8_STAGE(PG8_SA(0, 1), cA + hstep, voffA);
        if (wr == 1) PG8_BAR;
        PG8_WAIT_V(4); PG8_BAR;
        PG8_STAGE(PG8_SB(1, 0), cB + kstep, voffB); PG8_STAGE(PG8_SA(1, 0), cA + kstep, voffA); PG8_STAGE(PG8_SB(1, 1), cB + hstep + kstep, voffB);
        PG8_WAIT_V(6); PG8_BAR;
    }
    for (;;) {
        const bool has_next = S.next(ui + 1, nxt);
        const char* nA = has_next ? (const char*)g.A + (size_t)nxt.pm * tstep : cA; const char* nB = has_next ? (const char*)g.Bt + (size_t)nxt.pn * tstep : cB;
        for (int t = 0; t < nt; t += 2) {
            const bool last = (t == nt - 2);
            const char* a1 = cA + (size_t)(t + 1) * kstep;
            const char* a2 = last ? nA : cA + (size_t)(t + 2) * kstep; const char* b2 = last ? nB : cB + (size_t)(t + 2) * kstep;
            const char* a3 = a2 + kstep; const char* b3 = b2 + kstep;
            if (last && has_next) S.a_ready(nxt);
            if constexpr (SP2) {
            PG8_LDB(B0, 0, 0); PG8_LDB(B1, 0, 1); PG8_SCHED; PG8_LDA(At, 0, 0); PG8_STAGE(PG8_SA(1, 1), a1 + hstep, voffA);
            PG8_WAIT_V(8); PG8_WAIT_L(0); PG8_BAR; PG8_MMA(0, 0, At, B0); PG8_MMA(0, 1, At, B1); PG8_BAR; PG8_SCHED;
            PG8_LDA(At, 0, 1); PG8_STAGE(PG8_SB(0, 0), b2, voffB); PG8_STAGE(PG8_SB(0, 1), b2 + hstep, voffB); PG8_STAGE(PG8_SA(0, 0), a2, voffA);
            PG8_WAIT_V(8); PG8_WAIT_L(0); PG8_BAR; PG8_MMA(1, 0, At, B0); PG8_MMA(1, 1, At, B1); PG8_BAR; PG8_SCHED;
            PG8_LDB(B0, 1, 0); PG8_LDB(B1, 1, 1); PG8_SCHED; PG8_LDA(At, 1, 0); PG8_STAGE(PG8_SA(0, 1), a2 + hstep, voffA);
            PG8_WAIT_V(8); PG8_WAIT_L(0); PG8_BAR; PG8_MMA(0, 0, At, B0); PG8_MMA(0, 1, At, B1); PG8_BAR; PG8_SCHED;
            PG8_LDA(At, 1, 1); PG8_STAGE(PG8_SB(1, 0), b3, voffB); PG8_STAGE(PG8_SB(1, 1), b3 + hstep, voffB); PG8_STAGE(PG8_SA(1, 0), a3, voffA);
            PG8_WAIT_V(8); PG8_WAIT_L(0); PG8_BAR; PG8_MMA(1, 0, At, B0); PG8_MMA(1, 1, At, B1); PG8_BAR; PG8_SCHED;
            } else {
            PG8_LDB(B0, 0, 0); PG8_SCHED; PG8_LDA(At, 0, 0); PG8_STAGE(PG8_SA(1, 1), a1 + hstep, voffA);
            PG8_WAIT_L(8); PG8_BAR; PG8_WAIT_L(0); PG8_MMA(0, 0, At, B0); PG8_BAR; PG8_SCHED;
            PG8_LDB(B1, 0, 1); PG8_STAGE(PG8_SB(0, 0), b2, voffB);
            PG8_BAR; PG8_WAIT_L(0); PG8_MMA(0, 1, At, B1); PG8_BAR;
            PG8_LDA(At, 0, 1); PG8_STAGE(PG8_SA(0, 0), a2, voffA);
            PG8_BAR; PG8_WAIT_L(0); PG8_MMA(1, 0, At, B0); PG8_BAR; PG8_SCHED;
            PG8_STAGE(PG8_SB(0, 1), b2 + hstep, voffB);
            PG8_WAIT_V(6); PG8_BAR; PG8_MMA(1, 1, At, B1); PG8_BAR;
            PG8_LDB(B0, 1, 0); PG8_SCHED; PG8_LDA(At, 1, 0); PG8_STAGE(PG8_SA(0, 1), a2 + hstep, voffA);
            PG8_WAIT_L(8); PG8_BAR; PG8_WAIT_L(0); PG8_MMA(0, 0, At, B0); PG8_BAR; PG8_SCHED;
            PG8_LDB(B1, 1, 1); PG8_STAGE(PG8_SB(1, 0), b3, voffB);
            PG8_BAR; PG8_WAIT_L(0); PG8_MMA(0, 1, At, B1); PG8_BAR;
            PG8_LDA(At, 1, 1); PG8_STAGE(PG8_SA(1, 0), a3, voffA);
            PG8_BAR; PG8_WAIT_L(0); PG8_MMA(1, 0, At, B0); PG8_BAR; PG8_SCHED;
            PG8_STAGE(PG8_SB(1, 1), b3 + hstep, voffB);
            PG8_WAIT_V(6); PG8_BAR; PG8_MMA(1, 1, At, B1); PG8_BAR;
            }
        }
        if constexpr (ALIGN_EPI) { if (wr == 0) PG8_BAR; }
        if constexpr (!Epi::AFTER_DRAIN) { E(acc, cur, wr, wc, fr, fq); S.done(cur); }
        if (!has_next) break;
#pragma unroll
        for (int a = 0; a < 2; ++a)
#pragma unroll
            for (int b = 0; b < 2; ++b)
#pragma unroll
                for (int m = 0; m < 4; ++m)
#pragma unroll
                    for (int n = 0; n < 2; ++n) acc[a][b][m][n] = (f32x4){0.f, 0.f, 0.f, 0.f};
        cur = nxt; cA = nA; cB = nB; ++ui;
        if constexpr (ALIGN_EPI) { if (wr == 1) PG8_BAR; }
    }
    PG8_WAIT_V(0);
    if constexpr (!ALIGN_EPI) { if (wr == 0) PG8_BAR; }
    PG8_BAR;
#undef PG8_SA
#undef PG8_SB
#undef PG8_STAGE
#undef PG8_LDA
#undef PG8_LDB
#undef PG8_MMA
#undef PG8_WAIT_V
#undef PG8_WAIT_L
#undef PG8_BAR
#undef PG8_SCHED
}
}

struct EpiGate {
    static constexpr bool PERM = false, AFTER_DRAIN = false;
    h16_t* cu; h16_t* bsz;
    __device__ __forceinline__ void operator()(const f32x4 (&acc)[2][2][4][2], const pg8::Unit& u, int wr, int wc, int fr, int fq) const {
        const int row0 = u.pm * 256 + wr * 64 + fr, ch0 = u.pn * 64 + wc * 16 + fq * 4;
#pragma unroll
        for (int ai = 0; ai < 2; ++ai)
#pragma unroll
            for (int m = 0; m < 4; ++m) {
                const size_t off = (size_t)(row0 + ai * 128 + m * 16) * CONV_D + ch0;
                const f32x4 b = acc[ai][0][m][0], c = acc[ai][0][m][1], uu = acc[ai][1][m][0], z = acc[ai][1][m][1];
                const f32x4 cv = c * uu;
                f32x4 sv;
#pragma unroll
                for (int e = 0; e < 4; ++e) sv[e] = b[e] * silu_f(z[e]);
                u32x2 w0, w1; w0.x = pk2h(cv[0], cv[1]); w0.y = pk2h(cv[2], cv[3]); w1.x = pk2h(sv[0], sv[1]); w1.y = pk2h(sv[2], sv[3]);
                *(u32x2*)(cu + off) = w0; *(u32x2*)(bsz + off) = w1;
            }
    }
};
template <bool WB> struct EpiRes {
    static constexpr bool PERM = false, AFTER_DRAIN = false;
    const float* res; float* out; h16_t* hb; float* ss;
    __device__ __forceinline__ void operator()(const f32x4 (&acc)[2][2][4][2], const pg8::Unit& u, int wr, int wc, int fr, int fq) const {
        const int row0 = u.pm * 256 + wr * 64 + fr, col0 = u.pn * 256 + wc * 32 + 4 * fq;
#pragma unroll
        for (int ai = 0; ai < 2; ++ai)
#pragma unroll
            for (int m = 0; m < 4; ++m) {
                const int row = row0 + ai * 128 + m * 16; const size_t off = (size_t)row * D_MODEL + col0; float s = 0.f;
#pragma unroll
                for (int bj = 0; bj < 2; ++bj)
#pragma unroll
                    for (int n = 0; n < 2; ++n) {
                        const size_t o2 = off + bj * 128 + n * 16;
                        const f32x4 h = *(const f32x4*)(res + o2) + acc[ai][bj][m][n];
                        *(f32x4*)(out + o2) = h;
                        if (WB) { u32x2 w; w.x = pk2h(h[0], h[1]); w.y = pk2h(h[2], h[3]); *(u32x2*)(hb + o2) = w; }
                        s += (h[0] * h[0] + h[1] * h[1]) + (h[2] * h[2] + h[3] * h[3]);
                    }
                s += __shfl_xor(s, 16); s += __shfl_xor(s, 32);
                if (fq == 0) ss[(size_t)row * 16 + u.pn * 4 + wc] = s;
            }
    }
};
struct EpiQKV {
    static constexpr bool PERM = false, AFTER_DRAIN = false;
    const float* ss1; const float* rope; h16_t* kv; h16_t* q; h16_t* qrot; h16_t* sz; float* gates;
    __device__ __forceinline__ void operator()(const f32x4 (&acc)[2][2][4][2], const pg8::Unit& u, int wr, int wc, int fr, int fq) const {
        const int row0 = u.pm * 256 + wr * 64 + fr; const int pn = u.pn;
#pragma unroll
        for (int ai = 0; ai < 2; ++ai)
#pragma unroll
            for (int m = 0; m < 4; ++m) {
                const int row = row0 + ai * 128 + m * 16, t = row & (SEQ - 1), b = row >> 12;
                const f32x4 pp = *(const f32x4*)(ss1 + (size_t)row * 16 + fq * 4);
                float s = (pp[0] + pp[1]) + (pp[2] + pp[3]); s += __shfl_xor(s, 16); s += __shfl_xor(s, 32);
                const float rs = rsqrtf(s * (1.0f / D_MODEL) + EPS);
                const f32x4 rc = *(const f32x4*)(rope + (size_t)t * 16 + 4 * (fq & 1)), rsn = *(const f32x4*)(rope + (size_t)t * 16 + 8 + 4 * (fq & 1));
#pragma unroll
                for (int bj = 0; bj < 2; ++bj)
#pragma unroll
                    for (int n = 0; n < 2; ++n) {
                        const int col = bj * 128 + wc * 32 + n * 16 + 4 * fq;
                        f32x4 v = acc[ai][bj][m][n] * rs;
                        if (pn < 10) {
                            const bool isq = pn >= 6;
                            if (isq) v = v * 0.125f;
                            f32x4 vr = v;
                            if (n == 0 && (wc & 1) == 0) {
                                f32x4 pv;
#pragma unroll
                                for (int e = 0; e < 4; ++e) pv[e] = __shfl_xor(v[e], 32);
                                if (fq < 2) vr = v * rc - pv * rsn; else vr = v * rc + pv * rsn;
                            }
                            if (!isq) {
                                const int g = col >> 6, d = col & 63;
                                const bool roped = (pn == 2) || (pn == 4);
                                const f32x4 o = roped ? vr : v;
                                u32x2 w; w.x = pk2h(o[0], o[1]); w.y = pk2h(o[2], o[3]);
                                *(u32x2*)(kv + ((((size_t)pn * 4 + b) * 4 + g) * SEQ + t) * 64 + d) = w;
                            } else {
                                const size_t o2 = (size_t)row * D_MODEL + (pn - 6) * 256 + col;
                                u32x2 w; w.x = pk2h(v[0], v[1]); w.y = pk2h(v[2], v[3]); *(u32x2*)(q + o2) = w;
                                u32x2 w2; w2.x = pk2h(vr[0], vr[1]); w2.y = pk2h(vr[2], vr[3]); *(u32x2*)(qrot + o2) = w2;
                            }
                        } else if (pn < 14) {
                            f32x4 o;
#pragma unroll
                            for (int e = 0; e < 4; ++e) o[e] = silu_f(v[e]);
                            u32x2 w; w.x = pk2h(o[0], o[1]); w.y = pk2h(o[2], o[3]);
                            *(u32x2*)(sz + (size_t)row * D_MODEL + (pn - 10) * 256 + col) = w;
                        } else {
                            if (col < 48) {
                                f32x4 o;
#pragma unroll
                                for (int e = 0; e < 4; ++e) o[e] = sigmoid_f(v[e]);
                                *(f32x4*)(gates + (size_t)row * 48 + col) = o;
                            }
                        }
                    }
            }
    }
};

#define XB_TMO      128
#define XB_XCNT(j)  (256  + 64 * (j))
#define XB_XSUB(j)  (1280 + 64 * (j))
#define XB_XGEN(j)  (2304 + 64 * (j))
#define XB_TOP      3328
#define XB_TOPGEN   3392
#define XCD_BAR_WORDS 3456
#define XB_SPIN_CAP (1u << 18)
__device__ __forceinline__ unsigned xb_ld(unsigned* p)              { return __hip_atomic_load(p, __ATOMIC_RELAXED, __HIP_MEMORY_SCOPE_AGENT); }
__device__ __forceinline__ unsigned xb_add(unsigned* p, unsigned v) { return __hip_atomic_fetch_add(p, v, __ATOMIC_RELAXED, __HIP_MEMORY_SCOPE_AGENT); }
__device__ __forceinline__ unsigned xb_xcc_id() { return (unsigned)__builtin_amdgcn_s_getreg((3 << 11) | 20) & 0xFu; }
#define XB_SPIN(cond, bar) do { unsigned _sp = 0; while (cond) { __builtin_amdgcn_s_sleep(1); \
    if ((++_sp & 255u) == 0u) { if (xb_ld(&(bar)[XB_TMO])) break; if (_sp > XB_SPIN_CAP) { atomicAdd(&(bar)[XB_TMO], 1u); break; } } } } while (0)
struct XcdBarrier { unsigned* bar; unsigned x; volatile LAS unsigned* st; };
__device__ __forceinline__ XcdBarrier xcd_barrier_post(unsigned* bar, volatile LAS unsigned* st) {
    XcdBarrier b; b.bar = bar; b.x = xb_xcc_id(); b.st = st;
    if (threadIdx.x == 0) (void)xb_add(&bar[XB_XCNT(b.x)], 1u);
    return b;
}
__device__ __forceinline__ void xcd_barrier_complete(unsigned* bar, unsigned x, unsigned& nloc, unsigned& nx) {
    const unsigned G = gridDim.x * gridDim.y * gridDim.z;
    unsigned sum, cnt, mine, sp = 0u;
    for (;;) {
        sum = 0u; cnt = 0u; mine = 0u;
#pragma unroll
        for (unsigned j = 0; j < 16; ++j) { const unsigned c = xb_ld(&bar[XB_XCNT(j)]); sum += c; cnt += (c > 0u) ? 1u : 0u; mine = (j == x) ? c : mine; }
        if (sum == G) break;
        __builtin_amdgcn_s_sleep(1);
        if ((++sp & 255u) == 0u) { if (xb_ld(&bar[XB_TMO])) break; if (sp > XB_SPIN_CAP) { atomicAdd(&bar[XB_TMO], 1u); break; } }
    }
    nloc = mine > 0u ? mine : 1u; nx = cnt > 0u ? cnt : 1u;
}
__device__ __forceinline__ void xcd_barrier(const XcdBarrier& b) {
    asm volatile("s_waitcnt vmcnt(0)" ::: "memory");
    __syncthreads();
    if (threadIdx.x == 0) {
        unsigned* bar = b.bar;
        __builtin_amdgcn_s_waitcnt(0);
        unsigned nloc = b.st[0], nx = b.st[1];
        if (nloc == 0u) { xcd_barrier_complete(bar, b.x, nloc, nx); b.st[0] = nloc; b.st[1] = nx; }
        const unsigned old = xb_add(&bar[XB_XSUB(b.x)], 1u);
        const unsigned gen = old / nloc;
        if (old + 1u == (gen + 1u) * nloc) {
            __builtin_amdgcn_fence(__ATOMIC_RELEASE, "agent");
            asm volatile("s_waitcnt vmcnt(0)" ::: "memory");
            const unsigned og = xb_add(&bar[XB_TOP], 1u);
            const unsigned tg = og / nx;
            if (og + 1u == (tg + 1u) * nx) xb_add(&bar[XB_TOPGEN], 1u);
            else XB_SPIN(xb_ld(&bar[XB_TOPGEN]) == tg, bar);
            __builtin_amdgcn_fence(__ATOMIC_ACQUIRE, "agent");
            xb_add(&bar[XB_XGEN(b.x)], 1u);
            asm volatile("s_waitcnt vmcnt(0)" ::: "memory");
        } else {
            XB_SPIN(xb_ld(&bar[XB_XGEN(b.x)]) == gen, bar);
            __builtin_amdgcn_fence(__ATOMIC_ACQUIRE, "agent");
            asm volatile("s_waitcnt vmcnt(0)" ::: "memory");
        }
    }
    __syncthreads();
}

struct Params {
    const float* x; const float* a_norm; const float* a_w_in; const float* a_conv_w; const float* a_w_out;
    const float* kv_norm; const float* w_kv; const float* cmp_pos_k; const float* cmp_w1_k; const float* cmp_w2_k;
    const float* cmp_pos_v; const float* cmp_w1_v; const float* cmp_w2_v; const float* b_norm; const float* b_w_in; const float* b_w_out; const float* final_norm;
    float* out; unsigned char* ws;
};
struct Args { Params p; int ph_lo, ph_hi; };

__device__ __forceinline__ int w1_src_col(int r) { const int j = r >> 8, rho = r & 255; const int s = 2 * (rho >> 7) + ((rho >> 4) & 1); const int c64 = 16 * ((rho >> 5) & 3) + (rho & 15); return s * CONV_D + 64 * j + c64; }
__device__ __forceinline__ int w3b_src_col(int r) { if (r < 1024) return r; if (r < 2048) return 1072 + (r - 1024); if (r < 2096) return 1024 + (r - 2048); return -1; }
__device__ __forceinline__ void tr_item(const float* W, int K, int N, h16_t* dst, const float* gain, int mode, int item, int lane, int wave) {
    const int kblocks = K >> 6; const int rb = item / kblocks, kb = item % kblocks;
    const int r = rb * 64 + lane, k0 = kb * 64 + wave * 8;
    int sc = r; if (mode == 1) sc = w1_src_col(r); else if (mode == 2) sc = w3b_src_col(r);
    float v[8];
#pragma unroll
    for (int i = 0; i < 8; ++i) { float w = 0.f; if (sc >= 0) { w = W[(size_t)(k0 + i) * N + sc]; if (gain) w *= gain[k0 + i]; } v[i] = w; }
    u32x4 o; o.x = pk2h(v[0], v[1]); o.y = pk2h(v[2], v[3]); o.z = pk2h(v[4], v[5]); o.w = pk2h(v[6], v[7]);
    *(u32x4*)(dst + (size_t)r * K + k0) = o;
}
__device__ __forceinline__ void phase_prologue(const Params& p, int tid, int lane, int wave, int bid, int G) {
    unsigned char* ws = p.ws;
    constexpr int I0 = 128 * 16, I1 = 16 * 32, I2 = 24 * 16, I3 = 36 * 16, I4 = 16 * 16, I5 = 4 * 32, I6 = 4 * 32, I7 = 4, I8 = 4;
    constexpr int NIT = I0 + I1 + I2 + I3 + I4 + I5 + I6 + I7 + I8;
    for (int it = bid; it < NIT; it += G) {
        int r = it;
        if (r < I0) { tr_item(p.a_w_in, 1024, 8192, (h16_t*)(ws + WS_W1T), p.a_norm, 1, r, lane, wave); continue; } r -= I0;
        if (r < I1) { tr_item(p.a_w_out, 2048, 1024, (h16_t*)(ws + WS_W2T), nullptr, 0, r, lane, wave); continue; } r -= I1;
        if (r < I2) { tr_item(p.w_kv, 1024, 1536, (h16_t*)(ws + WS_W3T), p.kv_norm, 0, r, lane, wave); continue; } r -= I2;
        if (r < I3) { tr_item(p.b_w_in, 1024, 2096, (h16_t*)(ws + WS_W3T) + (size_t)1536 * 1024, p.b_norm, 2, r, lane, wave); continue; } r -= I3;
        if (r < I4) { tr_item(p.b_w_out, 1024, 1024, (h16_t*)(ws + WS_W4T), nullptr, 0, r, lane, wave); continue; } r -= I4;
        if (r < I5) { tr_item(p.cmp_w1_k, 2048, 256, (h16_t*)(ws + WS_CW1K), nullptr, 0, r, lane, wave); continue; } r -= I5;
        if (r < I6) { tr_item(p.cmp_w1_v, 2048, 256, (h16_t*)(ws + WS_CW1V), nullptr, 0, r, lane, wave); continue; } r -= I6;
        if (r < I7) { tr_item(p.cmp_w2_k, 256, 64, (h16_t*)(ws + WS_CW2K), nullptr, 0, r, lane, wave); continue; } r -= I7;
        tr_item(p.cmp_w2_v, 256, 64, (h16_t*)(ws + WS_CW2V), nullptr, 0, r, lane, wave);
    }
    const int gw = bid * NWAVES + wave, NGW = G * NWAVES;
    for (int m = gw; m < M_ROWS; m += NGW) {
        const f32x4* xr = (const f32x4*)(p.x + (size_t)m * D_MODEL) + lane;
        f32x4 v[4]; float s = 0.f;
#pragma unroll
        for (int j = 0; j < 4; ++j) { v[j] = xr[64 * j]; s += (v[j][0] * v[j][0] + v[j][1] * v[j][1]) + (v[j][2] * v[j][2] + v[j][3] * v[j][3]); }
        const float rs = rsqrtf(wave_sum(s) * (1.0f / D_MODEL) + EPS);
        u32x2* o8 = (u32x2*)((h16_t*)(ws + WS_XN) + (size_t)m * D_MODEL) + lane;
#pragma unroll
        for (int j = 0; j < 4; ++j) { u32x2 w; w.x = pk2h(v[j][0] * rs, v[j][1] * rs); w.y = pk2h(v[j][2] * rs, v[j][3] * rs); o8[64 * j] = w; }
    }
    const int gt = bid * NTHREADS + tid, NGT = G * NTHREADS;
    float* rope = (float*)(ws + WS_ROPE);
    for (int i = gt; i < SEQ * 8; i += NGT) {
        const int t = i >> 3, f = i & 7;
        const float inv = powf(500000.0f, -(float)f * 0.125f);
        const float ang = (float)t * inv;
        rope[t * 16 + f] = cosf(ang); rope[t * 16 + 8 + f] = sinf(ang);
    }
    float* cbp = (float*)(ws + WS_CBP);
    for (int it = bid; it < 64; it += G) {
        const int which = it >> 5, sl = it & 31;
        const float* pos = which ? p.cmp_pos_v : p.cmp_pos_k; const float* w1 = which ? p.cmp_w1_v : p.cmp_w1_k;
        if (tid < 256) { float a = 0.f;
            for (int k = 0; k < 64; ++k) a += pos[sl * 64 + k] * w1[(size_t)(sl * 64 + k) * 256 + tid];
            cbp[(which * 32 + sl) * 256 + tid] = a; }
    }
}

__device__ __forceinline__ void phase_conv(const Params& p, int tid, int bid, int G) {
    const h16_t* cu = (const h16_t*)(p.ws + WS_CU); h16_t* bsz = (h16_t*)(p.ws + WS_BSZ);
    const int gt = bid * NTHREADS + tid, NGT = G * NTHREADS;
    for (int it = gt; it < (M_ROWS / 16) * 256; it += NGT) {
        const int chunk = it & 255, strip = it >> 8; const int r0 = strip * 16, ch = chunk * 8;
        float w0[8], w1[8], w2[8], p1[8], p2[8];
#pragma unroll
        for (int e = 0; e < 8; ++e) { w0[e] = p.a_conv_w[ch + e]; w1[e] = p.a_conv_w[CONV_D + ch + e]; w2[e] = p.a_conv_w[2 * CONV_D + ch + e]; p1[e] = 0.f; p2[e] = 0.f; }
        if ((r0 & (SEQ - 1)) != 0) {
            const u32x4 a = *(const u32x4*)(cu + (size_t)(r0 - 2) * CONV_D + ch), b = *(const u32x4*)(cu + (size_t)(r0 - 1) * CONV_D + ch);
#pragma unroll
            for (int e = 0; e < 4; ++e) { p2[2 * e] = h_lo(a[e]); p2[2 * e + 1] = h_hi(a[e]); p1[2 * e] = h_lo(b[e]); p1[2 * e + 1] = h_hi(b[e]); }
        }
        for (int r = r0; r < r0 + 16; ++r) {
            const u32x4 cw = *(const u32x4*)(cu + (size_t)r * CONV_D + ch), sw = *(const u32x4*)(bsz + (size_t)r * CONV_D + ch);
            float c[8], sv[8], y[8];
#pragma unroll
            for (int e = 0; e < 4; ++e) { c[2 * e] = h_lo(cw[e]); c[2 * e + 1] = h_hi(cw[e]); sv[2 * e] = h_lo(sw[e]); sv[2 * e + 1] = h_hi(sw[e]); }
#pragma unroll
            for (int e = 0; e < 8; ++e) { y[e] = sv[e] * (w0[e] * p2[e] + w1[e] * p1[e] + w2[e] * c[e]); p2[e] = p1[e]; p1[e] = c[e]; }
            u32x4 o; o.x = pk2h(y[0], y[1]); o.y = pk2h(y[2], y[3]); o.z = pk2h(y[4], y[5]); o.w = pk2h(y[6], y[7]);
            *(u32x4*)(bsz + (size_t)r * CONV_D + ch) = o;
        }
    }
}

__device__ __forceinline__ void phase_compress(const Params& p, LAS unsigned char* lds, int lane, int wave, int bid, int G) {
    const int r = lane & 31, h = lane >> 5;
    LAS h16_t* hs = (LAS h16_t*)lds;
    for (int it = bid; it < 256; it += G) {
        const int which = it >> 7, bg = (it >> 3) & 15, rt = it & 7, n0 = rt * 32;
        const h16_t* kc = (const h16_t*)(p.ws + WS_KV) + (size_t)which * (16 * SEQ * 64) + (size_t)bg * SEQ * 64;
        const h16_t* w1t = (const h16_t*)(p.ws + (which ? WS_CW1V : WS_CW1K));
        const h16_t* w2t = (const h16_t*)(p.ws + (which ? WS_CW2V : WS_CW2K));
        const float* cbp = (const float*)(p.ws + WS_CBP) + which * 32 * 256;
        h16_t* outp = (h16_t*)(p.ws + (which ? WS_VCMP : WS_KCMP)) + (size_t)bg * 256 * 64;
        {
            f32x16 acc;
#pragma unroll
            for (int i = 0; i < 16; ++i) acc[i] = 0.f;
            asm volatile("" : "+v"(acc));
            const h16_t* arow = kc + (size_t)(n0 + r) * 1024 + 8 * h;
            const h16_t* brow = w1t + (size_t)(32 * wave + r) * 2048 + 8 * h;
#pragma unroll 8
            for (int s = 0; s < 128; ++s) {
                const h16x8 a = *(const h16x8*)(arow + 16 * s), b = *(const h16x8*)(brow + 16 * s);
                acc = MFMA32(a, b, acc);
            }
            const int col = 32 * wave + r; float bias = 0.f;
            for (int s = 0; s < 32; ++s) bias += cbp[s * 256 + col];
#pragma unroll
            for (int i = 0; i < 16; ++i) { const int row = (i & 3) + 8 * (i >> 2) + 4 * h; const float g = gelu_tanh_f(acc[i] + bias);
                hs[row * 256 + col] = f2h(g); }
        }
        __syncthreads();
        if (wave < 2) {
            f32x16 o;
#pragma unroll
            for (int i = 0; i < 16; ++i) o[i] = 0.f;
            asm volatile("" : "+v"(o));
#pragma unroll
            for (int s = 0; s < 16; ++s) {
                const h16x8 a = *(const LAS h16x8*)(hs + r * 256 + 16 * s + 8 * h);
                const h16x8 b = *(const h16x8*)(w2t + (size_t)(32 * wave + r) * 256 + 16 * s + 8 * h);
                o = MFMA32(a, b, o);
            }
#pragma unroll
            for (int i = 0; i < 16; ++i) { const int row = (i & 3) + 8 * (i >> 2) + 4 * h; const int n = n0 + row;
                outp[(size_t)n * 64 + 32 * wave + r] = (n < 255) ? f2h(o[i]) : (h16_t)0; }
        }
        __syncthreads();
    }
}

constexpr int NAIVE_WAVES = 6, NAIVE_F = 5648;
__device__ __forceinline__ void dot4(const h16_t* krow, const LAS float* qv, float& a0, float& a1, float& a2, float& a3) {
    a0 = 0.f; a1 = 0.f; a2 = 0.f; a3 = 0.f;
#pragma unroll
    for (int c = 0; c < 8; ++c) {
        const u32x4 kk = *(const u32x4*)(krow + c * 8);
#pragma unroll
        for (int e = 0; e < 4; ++e) {
            const float k0 = h_lo(kk[e]), k1 = h_hi(kk[e]); const int d = c * 8 + 2 * e;
            a0 += k0 * qv[d] + k1 * qv[d + 1]; a1 += k0 * qv[64 + d] + k1 * qv[64 + d + 1];
            a2 += k0 * qv[128 + d] + k1 * qv[128 + d + 1]; a3 += k0 * qv[192 + d] + k1 * qv[192 + d + 1];
        }
    }
}
__device__ __forceinline__ float softmax_row(LAS float* S, int cnt, int lane) {
    float m = -INFINITY;
    for (int k = lane; k < cnt; k += 64) m = fmaxf(m, S[k]);
    m = wave_max(m); if (!(m > -INFINITY)) m = 0.f;
    float sum = 0.f;
    for (int k = lane; k < cnt; k += 64) { const float s = S[k]; const float e = (s > -INFINITY) ? __expf(s - m) : 0.f; S[k] = e; sum += e; }
    sum = wave_sum(sum);
    return 1.0f / fmaxf(sum, 1e-30f);
}
__device__ __forceinline__ void phase_attn_naive(const Params& p, LAS unsigned char* lds, int lane, int wave, int bid, int G) {
    if (wave >= NAIVE_WAVES) return;
    LAS float* L = (LAS float*)lds + wave * NAIVE_F;
    LAS float* qs = L; LAS float* qrs = L + 256; LAS float* pc = L + 512; LAS float* sc = L + 1536; LAS int* sel = (LAS int*)(L + 5632);
    const h16_t* qb = (const h16_t*)(p.ws + WS_Q); const h16_t* qrb = (const h16_t*)(p.ws + WS_QROT);
    const h16_t* kvb = (const h16_t*)(p.ws + WS_KV); const h16_t* szb = (const h16_t*)(p.ws + WS_SZ);
    const float* gates = (const float*)(p.ws + WS_GATES); h16_t* y2 = (h16_t*)(p.ws + WS_XN);
    const int gw = bid * NAIVE_WAVES + wave, NGW = G * NAIVE_WAVES;
    for (int item = gw; item < M_ROWS * N_GROUPS; item += NGW) {
        const int g = item & 3, bt = item >> 2, b = bt >> 12, t = bt & (SEQ - 1);
        { const u32x2 a = *(const u32x2*)(qb + (size_t)bt * D_MODEL + g * 256 + 4 * lane), c = *(const u32x2*)(qrb + (size_t)bt * D_MODEL + g * 256 + 4 * lane);
          qs[4 * lane] = h_lo(a.x); qs[4 * lane + 1] = h_hi(a.x); qs[4 * lane + 2] = h_lo(a.y); qs[4 * lane + 3] = h_hi(a.y);
          qrs[4 * lane] = h_lo(c.x); qrs[4 * lane + 1] = h_hi(c.x); qrs[4 * lane + 2] = h_lo(c.y); qrs[4 * lane + 3] = h_hi(c.y); }
        const size_t bgoff = ((size_t)b * 4 + g) * SEQ * 64; const size_t strm = (size_t)16 * SEQ * 64;
        const h16_t* kcmp = (const h16_t*)(p.ws + WS_KCMP) + ((size_t)b * 4 + g) * 256 * 64; const h16_t* vcmp = (const h16_t*)(p.ws + WS_VCMP) + ((size_t)b * 4 + g) * 256 * 64;
        const h16_t* ks = kvb + 2 * strm + bgoff; const h16_t* vs = kvb + 3 * strm + bgoff; const h16_t* kw = kvb + 4 * strm + bgoff; const h16_t* vw = kvb + 5 * strm + bgoff;
        const int nv = t >= 31 ? ((t - 31) >> 4) + 1 : 0;
        for (int n = lane; n < 256; n += 64) {
            float a0 = -INFINITY, a1 = -INFINITY, a2 = -INFINITY, a3 = -INFINITY;
            if (n < nv) dot4(kcmp + (size_t)n * 64, qs, a0, a1, a2, a3);
            pc[n] = a0; pc[256 + n] = a1; pc[512 + n] = a2; pc[768 + n] = a3;
        }
        float oc0 = 0.f, oc1 = 0.f, oc2 = 0.f, oc3 = 0.f;
        {
            const float i0 = softmax_row(pc, 256, lane), i1 = softmax_row(pc + 256, 256, lane), i2 = softmax_row(pc + 512, 256, lane), i3 = softmax_row(pc + 768, 256, lane);
            for (int n = lane; n < 256; n += 64) { pc[n] *= i0; pc[256 + n] *= i1; pc[512 + n] *= i2; pc[768 + n] *= i3; }
            for (int n = 0; n < nv; ++n) { const float v = h2f(vcmp[(size_t)n * 64 + lane]); oc0 += pc[n] * v; oc1 += pc[256 + n] * v; oc2 += pc[512 + n] * v; oc3 += pc[768 + n] * v; }
        }
        unsigned long long mask;
        {
            float imp = 0.f;
#pragma unroll
            for (int hh = 0; hh < 4; ++hh) {
                const LAS float* P = pc + hh * 256; const int j4 = 4 * lane;
                const float pm1 = (lane > 0) ? P[j4 - 1] : 0.f;
                imp += pm1 + 2.0f * (P[j4] + P[j4 + 1] + P[j4 + 2]) + P[j4 + 3];
            }
            const int cur = t >> 6; const bool valid = lane <= cur; const bool forced = (lane == 0) || (valid && lane > cur - 2);
            const float score = valid ? (forced ? 1e4f : imp) : -INFINITY;
            int rank = 0;
            for (int k = 0; k < 64; ++k) { const float sk = __shfl(score, k); rank += ((sk > score) || (sk == score && k < lane)) ? 1 : 0; }
            const bool selected = valid && rank < 16;
            mask = __ballot(selected);
            if (selected) sel[__popcll(mask & ((1ull << lane) - 1ull))] = lane;
        }
        const int nsel = __popcll(mask);
        float os0 = 0.f, os1 = 0.f, os2 = 0.f, os3 = 0.f;
        {
            const int cnt = nsel * 64;
            for (int kk = lane; kk < cnt; kk += 64) {
                const int kpos = sel[kk >> 6] * 64 + (kk & 63);
                float a0 = -INFINITY, a1 = -INFINITY, a2 = -INFINITY, a3 = -INFINITY;
                if (kpos <= t) dot4(ks + (size_t)kpos * 64, qrs, a0, a1, a2, a3);
                sc[kk] = a0; sc[1024 + kk] = a1; sc[2048 + kk] = a2; sc[3072 + kk] = a3;
            }
            const float i0 = softmax_row(sc, cnt, lane), i1 = softmax_row(sc + 1024, cnt, lane), i2 = softmax_row(sc + 2048, cnt, lane), i3 = softmax_row(sc + 3072, cnt, lane);
            for (int kk = 0; kk < cnt; ++kk) {
                const int kpos = sel[kk >> 6] * 64 + (kk & 63);
                const float v = h2f(vs[(size_t)kpos * 64 + lane]);
                os0 += sc[kk] * v; os1 += sc[1024 + kk] * v; os2 += sc[2048 + kk] * v; os3 += sc[3072 + kk] * v;
            }
            os0 *= i0; os1 *= i1; os2 *= i2; os3 *= i3;
        }
        float ow0 = 0.f, ow1 = 0.f, ow2 = 0.f, ow3 = 0.f;
        {
            const int nk = (t + 1 < 512) ? t + 1 : 512; const int k0 = t - nk + 1;
            for (int kk = lane; kk < nk; kk += 64) {
                float a0, a1, a2, a3; dot4(kw + (size_t)(k0 + kk) * 64, qrs, a0, a1, a2, a3);
                sc[kk] = a0; sc[1024 + kk] = a1; sc[2048 + kk] = a2; sc[3072 + kk] = a3;
            }
            const float i0 = softmax_row(sc, nk, lane), i1 = softmax_row(sc + 1024, nk, lane), i2 = softmax_row(sc + 2048, nk, lane), i3 = softmax_row(sc + 3072, nk, lane);
            for (int kk = 0; kk < nk; ++kk) {
                const float v = h2f(vw[(size_t)(k0 + kk) * 64 + lane]);
                ow0 += sc[kk] * v; ow1 += sc[1024 + kk] * v; ow2 += sc[2048 + kk] * v; ow3 += sc[3072 + kk] * v;
            }
            ow0 *= i0; ow1 *= i1; ow2 *= i2; ow3 *= i3;
        }
        {
            const float* gr = gates + (size_t)bt * 48 + g * 12;
            const size_t o = (size_t)bt * D_MODEL + g * 256 + lane;
            const float r0 = (gr[0] * oc0 + gr[1] * os0 + gr[2] * ow0) * h2f(szb[o]);
            const float r1 = (gr[3] * oc1 + gr[4] * os1 + gr[5] * ow1) * h2f(szb[o + 64]);
            const float r2 = (gr[6] * oc2 + gr[7] * os2 + gr[8] * ow2) * h2f(szb[o + 128]);
            const float r3 = (gr[9] * oc3 + gr[10] * os3 + gr[11] * ow3) * h2f(szb[o + 192]);
            y2[o] = f2h(r0); y2[o + 64] = f2h(r1);
            y2[o + 128] = f2h(r2); y2[o + 192] = f2h(r3);
        }
    }
}

__device__ __forceinline__ void phase_final(const Params& p, int lane, int wave, int bid, int G) {
    const float* ss2 = (const float*)(p.ws + WS_SS2);
    const int gw = bid * NWAVES + wave, NGW = G * NWAVES;
    for (int m = gw; m < M_ROWS; m += NGW) {
        float s = (lane < 16) ? ss2[(size_t)m * 16 + lane] : 0.f; s = wave_sum(s);
        const float rs = rsqrtf(s * (1.0f / D_MODEL) + EPS);
        f32x4* xr = (f32x4*)(p.out + (size_t)m * D_MODEL) + lane; const f32x4* gr = (const f32x4*)p.final_norm + lane;
#pragma unroll
        for (int j = 0; j < 4; ++j) { const f32x4 v = xr[64 * j], g = gr[64 * j]; xr[64 * j] = v * rs * g; }
    }
}


#ifndef DIAG
#define DIAG 0
#endif
__device__ __forceinline__ void diag_scan_buf(const void* ptr, size_t n, bool is_fp16, int bufid, unsigned* ctl, int gt, int NGT) {
    unsigned bad = 0; float mx = 0.f;
    for (size_t i = gt; i < n; i += NGT) {
        float v = is_fp16 ? h2f(((const h16_t*)ptr)[i]) : ((const float*)ptr)[i];
        if (!(fabsf(v) < 3.0e38f)) bad++; else mx = fmaxf(mx, fabsf(v));
    }
    if (bad) atomicAdd(&ctl[8192 + bufid], bad);
    atomicMax(&ctl[8256 + bufid], __float_as_uint(mx));
}
__device__ __forceinline__ void phase_diag_scan(const Params& p, int tid, int bid, int G) {
    unsigned* ctl = (unsigned*)(p.ws + WS_CTL); const int gt = bid * NTHREADS + tid, NGT = G * NTHREADS; unsigned char* ws = p.ws;
    diag_scan_buf(ws + WS_Q, (size_t)M_ROWS * 1024, true, 0, ctl, gt, NGT);
    diag_scan_buf(ws + WS_QROT, (size_t)M_ROWS * 1024, true, 1, ctl, gt, NGT);
    diag_scan_buf(ws + WS_KV, (size_t)6 * 16 * SEQ * 64, true, 2, ctl, gt, NGT);
    diag_scan_buf(ws + WS_SZ, (size_t)M_ROWS * 1024, true, 3, ctl, gt, NGT);
    diag_scan_buf(ws + WS_KCMP, (size_t)16 * 256 * 64, true, 4, ctl, gt, NGT);
    diag_scan_buf(ws + WS_VCMP, (size_t)16 * 256 * 64, true, 5, ctl, gt, NGT);
    diag_scan_buf(ws + WS_GATES, (size_t)M_ROWS * 48, false, 6, ctl, gt, NGT);
    diag_scan_buf(ws + WS_SS1, (size_t)M_ROWS * 16, false, 7, ctl, gt, NGT);
    diag_scan_buf(ws + WS_ROPE, (size_t)SEQ * 16, false, 8, ctl, gt, NGT);
    diag_scan_buf(ws + WS_CBP, (size_t)2 * 32 * 256, false, 9, ctl, gt, NGT);
    diag_scan_buf(ws + WS_XN, (size_t)M_ROWS * 1024, true, 10, ctl, gt, NGT);
    diag_scan_buf(ws + WS_CW1K, (size_t)256 * 2048, true, 11, ctl, gt, NGT);
    diag_scan_buf(ws + WS_CW1V, (size_t)256 * 2048, true, 12, ctl, gt, NGT);
    diag_scan_buf(ws + WS_CW2K, (size_t)64 * 256, true, 13, ctl, gt, NGT);
    diag_scan_buf(ws + WS_CW2V, (size_t)64 * 256, true, 14, ctl, gt, NGT);
}
__device__ __forceinline__ void phase_diag_report(const Params& p, int tid, int bid, int G) {
    unsigned* ctl = (unsigned*)(p.ws + WS_CTL); const int gt = bid * NTHREADS + tid, NGT = G * NTHREADS;
    int first = -1; float mx = 0.f;
    for (int b = 14; b >= 0; --b) { if (ctl[8192 + b]) first = b; }
#if DIAG == 1
    for (int b = 0; b <= 14; ++b) mx = fmaxf(mx, __uint_as_float(ctl[8256 + b]));
#else
    for (int b = 11; b <= 14; ++b) mx = fmaxf(mx, __uint_as_float(ctl[8256 + b]));
#endif
    if (gt == 0) p.out[0] = 1.0e5f * (float)(2 + first);
    for (int i = 1024 + gt; i < 1024 + (1 << 20); i += NGT) p.out[i] = 100.0f * log2f(1.0f + mx);
}

__global__ void __launch_bounds__(NTHREADS, 2) yoco_fwd(Args args) {
    extern __shared__ __attribute__((aligned(16))) unsigned char lds_raw[];
    LAS unsigned char* lds = (LAS unsigned char*)lds_raw;
    const Params& p = args.p;
    const int tid = threadIdx.x, lane = tid & 63, wave = __builtin_amdgcn_readfirstlane(tid >> 6);
    const int G = gridDim.x, bid = blockIdx.x;
    unsigned char* ws = p.ws;
    for (int u = tid; u < (LDS_BYTES - LDSCTL_OFF) / 4; u += NTHREADS) ((LAS unsigned*)(lds + LDSCTL_OFF))[u] = 0u;
    __syncthreads();
    const int lo = args.ph_lo, hi = args.ph_hi;
    const bool multi = (hi - lo) > 1;
    XcdBarrier bar; bar.bar = (unsigned*)(ws + WS_CTL) + CW_BAR; bar.x = 0; bar.st = nullptr;
    if (multi) bar = xcd_barrier_post((unsigned*)(ws + WS_CTL) + CW_BAR, (volatile LAS unsigned*)(lds + LDSCTL_OFF) + 8);
#define IN(k) (lo <= (k) && (k) < hi)
#define SEAM(k) do { if (IN(k) && IN((k) + 1)) xcd_barrier(bar); } while (0)

    if (IN(0)) { phase_prologue(p, tid, lane, wave, bid, G); } SEAM(0);
    if (IN(1)) {
        pg8::Gemm g{(const h16_t*)(ws + WS_XN), (const h16_t*)(ws + WS_W1T), M_ROWS, 8192, 1024}; pg8::StaticOrder S; S.init(M_ROWS, 8192, G, bid);
        EpiGate E{(h16_t*)(ws + WS_CU), (h16_t*)(ws + WS_BSZ)};
        pg8::gemm_phase<EpiGate, pg8::StaticOrder, true, true>(lds, g, S, E);
    } SEAM(1);
    if (IN(2)) { phase_conv(p, tid, bid, G); } SEAM(2);
    if (IN(3)) {
        pg8::Gemm g{(const h16_t*)(ws + WS_BSZ), (const h16_t*)(ws + WS_W2T), M_ROWS, 1024, 2048}; pg8::StaticOrder S; S.init(M_ROWS, 1024, G, bid);
        EpiRes<true> E{p.x, p.out, (h16_t*)(ws + WS_XN), (float*)(ws + WS_SS1)};
        pg8::gemm_phase<EpiRes<true>, pg8::StaticOrder, true, true>(lds, g, S, E);
    } SEAM(3);
    if (IN(4)) {
        pg8::Gemm g{(const h16_t*)(ws + WS_XN), (const h16_t*)(ws + WS_W3T), M_ROWS, N3, 1024}; pg8::StaticOrder S; S.init(M_ROWS, N3, G, bid);
        EpiQKV E{(const float*)(ws + WS_SS1), (const float*)(ws + WS_ROPE), (h16_t*)(ws + WS_KV), (h16_t*)(ws + WS_Q), (h16_t*)(ws + WS_QROT), (h16_t*)(ws + WS_SZ), (float*)(ws + WS_GATES)};
        pg8::gemm_phase<EpiQKV, pg8::StaticOrder, true, true>(lds, g, S, E);
    } SEAM(4);
    if (IN(5)) { phase_compress(p, lds, lane, wave, bid, G); } SEAM(5);
#if DIAG
    if (IN(6)) { phase_diag_scan(p, tid, bid, G); } SEAM(6);
    if (IN(7)) { phase_diag_report(p, tid, bid, G); }
    if (IN(8)) { }
#else
    if (IN(6)) { phase_attn_naive(p, lds, lane, wave, bid, G); } SEAM(6);
    if (IN(7)) {
        pg8::Gemm g{(const h16_t*)(ws + WS_XN), (const h16_t*)(ws + WS_W4T), M_ROWS, 1024, 1024}; pg8::StaticOrder S; S.init(M_ROWS, 1024, G, bid);
        EpiRes<false> E{p.out, p.out, nullptr, (float*)(ws + WS_SS2)};
        pg8::gemm_phase<EpiRes<false>, pg8::StaticOrder, true, true>(lds, g, S, E);
    } SEAM(7);
    if (IN(8)) { phase_final(p, lane, wave, bid, G); }
#endif
#undef IN
#undef SEAM
}

#ifndef N_LAUNCH_SPLIT
#define N_LAUNCH_SPLIT 0
#endif
extern "C" void kernel_launch(void* const* d_in, const int* in_sizes, int n_in, void* d_out, int out_size, void* d_ws, size_t ws_size, hipStream_t stream) {
    static int grid = 0;
    if (grid == 0) {
        if (n_in != 17 || out_size != M_ROWS * D_MODEL || ws_size < WS_END) { fprintf(stderr, "kernel_launch: unexpected shapes (n_in %d out %d ws %zu)\n", n_in, out_size, ws_size); grid = -1; return; }
        int dev = 0, cus = 0, per_cu = 0;
        if (hipGetDevice(&dev) != hipSuccess || hipDeviceGetAttribute(&cus, hipDeviceAttributeMultiprocessorCount, dev) != hipSuccess) { grid = -1; return; }
        if (hipFuncSetAttribute((const void*)yoco_fwd, hipFuncAttributeMaxDynamicSharedMemorySize, LDS_BYTES) != hipSuccess) { fprintf(stderr, "kernel_launch: hipFuncSetAttribute failed\n"); grid = -1; return; }
        if (hipOccupancyMaxActiveBlocksPerMultiprocessor(&per_cu, (const void*)yoco_fwd, NTHREADS, LDS_BYTES) != hipSuccess || per_cu < 1)
            fprintf(stderr, "kernel_launch: occupancy query reports %d\n", per_cu);
        (void)hipGetLastError();
        grid = cus;
    }
    if (grid < 0) return;
    (void)hipMemsetAsync((char*)d_ws + WS_CTL, 0, CTL_ZERO_BYTES, stream);
    Args a{};
    const float** pp = (const float**)&a.p;
    for (int i = 0; i < 17; ++i) pp[i] = (const float*)d_in[i];
    a.p.out = (float*)d_out; a.p.ws = (unsigned char*)d_ws;
#if N_LAUNCH_SPLIT
#ifndef PH_MAX
#define PH_MAX N_PHASES
#endif
    for (int ph = 0; ph < PH_MAX; ++ph) { a.ph_lo = ph; a.ph_hi = ph + 1; hipLaunchKernelGGL(yoco_fwd, dim3(grid), dim3(NTHREADS), LDS_BYTES, stream, a); }
#else
    a.ph_lo = 0; a.ph_hi = N_PHASES; hipLaunchKernelGGL(yoco_fwd, dim3(grid), dim3(NTHREADS), LDS_BYTES, stream, a);
#endif
}
```

```cpp
#include <hip/hip_runtime.h>
#include <cstdio>
#include <cstdint>
#include <cmath>

#define LAS __attribute__((address_space(3)))
#define GAS __attribute__((address_space(1)))
typedef unsigned short h16_t;
typedef short h16x8 __attribute__((ext_vector_type(8)));
typedef float f32x4 __attribute__((ext_vector_type(4)));
typedef float f32x16 __attribute__((ext_vector_type(16)));
typedef unsigned u32x4 __attribute__((ext_vector_type(4)));
typedef unsigned u32x2 __attribute__((ext_vector_type(2)));

constexpr int D_MODEL = 1024, BATCH = 4, SEQ = 4096, M_ROWS = BATCH * SEQ;
constexpr int CONV_D = 2048, N_HEADS = 16, HEAD_DIM = 64, N_GROUPS = 4;
constexpr int N3 = 3840;
constexpr float EPS = 1e-6f;
constexpr int NWAVES = 8, NTHREADS = 512;
constexpr int N_PHASES = 9;

constexpr size_t MiB = 1u << 20;
constexpr size_t WS_CTL = 0, CTL_ZERO_BYTES = 1 * MiB;
constexpr size_t WS_ROPE = 1 * MiB;
constexpr size_t WS_SS1 = 1 * MiB + 512 * 1024;
constexpr size_t WS_SS2 = 2 * MiB + 512 * 1024;
constexpr size_t WS_CBP = 3 * MiB + 512 * 1024;
constexpr size_t WS_WIMP = 3 * MiB + 768 * 1024;
constexpr size_t WS_KCMP = 4 * MiB;
constexpr size_t WS_VCMP = 4 * MiB + 512 * 1024;
constexpr size_t WS_W1T = 8 * MiB;
constexpr size_t WS_W2T = 24 * MiB;
constexpr size_t WS_W3T = 28 * MiB;
constexpr size_t WS_W4T = 36 * MiB;
constexpr size_t WS_CW1K = 38 * MiB, WS_CW1V = 39 * MiB;
constexpr size_t WS_CW2K = 40 * MiB, WS_CW2V = 40 * MiB + 512 * 1024;
constexpr size_t WS_XN = 42 * MiB;
constexpr size_t WS_CU = 74 * MiB;
constexpr size_t WS_Q = 74 * MiB, WS_SZ = 106 * MiB;
constexpr size_t WS_BSZ = 138 * MiB;
constexpr size_t WS_KV = 138 * MiB, WS_GATES = 186 * MiB;
constexpr size_t WS_QROT = 202 * MiB;
constexpr size_t WS_END = 234 * MiB;
constexpr int CW_BAR = 4096;

constexpr int RING_BYTES = 131072;
constexpr int LDSCTL_OFF = 144384;
constexpr int LDS_BYTES = 147456;

typedef _Float16 f16x2 __attribute__((ext_vector_type(2)));
typedef _Float16 f16x8 __attribute__((ext_vector_type(8)));
__device__ __forceinline__ unsigned pk2h(float lo, float hi) { f16x2 v; v.x = (_Float16)lo; v.y = (_Float16)hi; return __builtin_bit_cast(unsigned, v); }
__device__ __forceinline__ h16_t f2h(float f) { return __builtin_bit_cast(unsigned short, (_Float16)f); }
__device__ __forceinline__ float h_lo(unsigned w) { return (float)__builtin_bit_cast(f16x2, w).x; }
__device__ __forceinline__ float h_hi(unsigned w) { return (float)__builtin_bit_cast(f16x2, w).y; }
__device__ __forceinline__ float h2f(h16_t h) { return (float)__builtin_bit_cast(_Float16, h); }
#define MFMA16(a, b, c) __builtin_amdgcn_mfma_f32_16x16x32_f16(__builtin_bit_cast(f16x8, a), __builtin_bit_cast(f16x8, b), c, 0, 0, 0)
#define MFMA32(a, b, c) __builtin_amdgcn_mfma_f32_32x32x16_f16(__builtin_bit_cast(f16x8, a), __builtin_bit_cast(f16x8, b), c, 0, 0, 0)
__device__ __forceinline__ float wave_sum(float v) {
#pragma unroll
    for (int o = 1; o < 64; o <<= 1) v += __shfl_xor(v, o);
    return v;
}
__device__ __forceinline__ float wave_max(float v) {
#pragma unroll
    for (int o = 1; o < 64; o <<= 1) v = fmaxf(v, __shfl_xor(v, o));
    return v;
}
constexpr float C2Q = 0.125f * 1.4426950408889634f;
__device__ __forceinline__ int kimg_off(int keyl, int d) { return (d >> 3) * 512 + keyl * 8 + (d & 7); }
__device__ __forceinline__ int vimg_off(int keyl, int d) { return ((d >> 5) * 4 + (keyl >> 4)) * 512 + (keyl & 15) * 32 + (d & 31); }
__device__ __forceinline__ float silu_f(float z) { return z / (1.0f + __expf(-z)); }
__device__ __forceinline__ float sigmoid_f(float z) { return 1.0f / (1.0f + __expf(-z)); }
__device__ __forceinline__ float gelu_tanh_f(float x) { const float u = 0.7978845608028654f * (x + 0.044715f * x * x * x); return 0.5f * x * (1.0f + tanhf(u)); }

namespace pg8 {
#define PG8_LAS __attribute__((address_space(3)))
constexpr int BM = 256, BK = 64, HALF = 128, HTB = HALF * BK * 2, STAGE_BYTES = 8 * HTB, NXCD = 8, WGM = 8;
__host__ __device__ __forceinline__ int lds_byte(int r, int c) { const int st = (r >> 4) * 2 + (c >> 5), rr = r & 15, cc = c & 31, ob = rr * 64 + cc * 2; return st * 1024 + (ob ^ (((ob >> 9) & 1) << 5)); }
__host__ __device__ __forceinline__ void stage_rc(int b, int& R, int& C) { const int st = b / 1024, sb = b % 1024, swz = sb ^ (((sb >> 9) & 1) << 5); R = (st >> 1) * 16 + swz / 64; C = (st & 1) * 32 + (swz % 64) / 2; }
__host__ __device__ __forceinline__ int perm32(int rho) { const int n = rho >> 4, i = rho & 15; return 8 * (i >> 2) + 4 * n + (i & 3); }
struct Unit { int pm, pn; };
struct Gemm { const h16_t* A; const h16_t* Bt; int M, N, K; };
struct StaticOrder {
    int nM, nN, nwg, G, c;
    __host__ __device__ void init(int M, int N, int G_, int c_) { nM = M / BM; nN = N / BM; nwg = nM * nN; G = G_; c = c_; }
    __host__ __device__ bool next(int i, Unit& u) const {
        const long L = (long)i * G + c; if (L >= nwg) return false;
        int wgid = (int)L; { const int q = nwg / NXCD, r = nwg % NXCD, xcd = wgid % NXCD, off = wgid / NXCD; wgid = (xcd < r ? xcd * (q + 1) : r * (q + 1) + (xcd - r) * q) + off; }
        const int nig = WGM * nN, gid = wgid / nig, fm = gid * WGM, gsz = (nM - fm) < WGM ? (nM - fm) : WGM;
        u.pm = fm + ((wgid % nig) % gsz); u.pn = (wgid % nig) / gsz; return true;
    }
    __device__ __forceinline__ void a_ready(const Unit&) const {}
    __device__ __forceinline__ void done(const Unit&) const {}
};

template <class Epi, class Sched, bool ALIGN_EPI = false, bool SP2 = false>
__device__ __forceinline__ void gemm_phase(PG8_LAS unsigned char* lds, const Gemm g, const Sched& S, const Epi& E) {
    const int tid = threadIdx.x, wid = __builtin_amdgcn_readfirstlane(tid >> 6), lane = tid & 63, wr = wid >> 2, wc = wid & 3, fr = lane & 15, fq = lane >> 4;
    const int K = g.K, nt = K / BK;
    unsigned voffA[2], voffB[2];
#pragma unroll
    for (int i = 0; i < 2; ++i) { int R, C; stage_rc(tid * 16 + i * 8192, R, C); const int Rb = Epi::PERM ? ((R & ~31) + perm32(R & 31)) : R;
        voffA[i] = (unsigned)(R * K + C) * 2u; voffB[i] = (unsigned)(Rb * K + C) * 2u; }
    const size_t kstep = (size_t)(BK * 2);
    const size_t hstep = (size_t)HALF * K * 2;
    const size_t tstep = 2 * hstep;
    const unsigned ldsw = (unsigned)wid * 1024u;
    const int aoff = lds_byte(wr * 64 + fr, fq * 8), boff = lds_byte(wc * 32 + fr, fq * 8);
#define PG8_SA(b, h) (((b) * 2 + (h)) * HTB)
#define PG8_SB(b, h) ((4 + (b) * 2 + (h)) * HTB)
#define PG8_STAGE(bufoff, gbase, voff) do { _Pragma("unroll") for (int _i = 0; _i < 2; ++_i) \
        __builtin_amdgcn_global_load_lds((const unsigned*)((const char*)(gbase) + (voff)[_i]), (PG8_LAS unsigned*)(lds + (bufoff) + ldsw + _i * 8192), 16, 0, 0); } while (0)
#define PG8_LDA(dst, b, h) do { _Pragma("unroll") for (int m = 0; m < 4; ++m) _Pragma("unroll") for (int k = 0; k < 2; ++k) dst[m][k] = *(const PG8_LAS h16x8*)(lds + PG8_SA(b, h) + aoff + m * 2048 + k * 1024); } while (0)
#define PG8_LDB(dst, b, h) do { _Pragma("unroll") for (int n = 0; n < 2; ++n) _Pragma("unroll") for (int k = 0; k < 2; ++k) dst[n][k] = *(const PG8_LAS h16x8*)(lds + PG8_SB(b, h) + boff + n * 2048 + k * 1024); } while (0)
#define PG8_MMA(ai, bj, At, Bt) do { __builtin_amdgcn_s_setprio(1); _Pragma("unroll") for (int m = 0; m < 4; ++m) _Pragma("unroll") for (int n = 0; n < 2; ++n) _Pragma("unroll") for (int k = 0; k < 2; ++k) \
        acc[ai][bj][m][n] = MFMA16(Bt[n][k], At[m][k], acc[ai][bj][m][n]); __builtin_amdgcn_s_setprio(0); } while (0)
#define PG8_WAIT_V(n) asm volatile("s_waitcnt vmcnt(" #n ")" ::: "memory")
#define PG8_WAIT_L(n) asm volatile("s_waitcnt lgkmcnt(" #n ")" ::: "memory")
#define PG8_BAR __builtin_amdgcn_s_barrier()
#define PG8_SCHED __builtin_amdgcn_sched_barrier(0)
    Unit cur, nxt; int ui = 0;
    if (!S.next(0, cur)) return;
    f32x4 acc[2][2][4][2];
#pragma unroll
    for (int a = 0; a < 2; ++a)
#pragma unroll
        for (int b = 0; b < 2; ++b)
#pragma unroll
            for (int m = 0; m < 4; ++m)
#pragma unroll
                for (int n = 0; n < 2; ++n) acc[a][b][m][n] = (f32x4){0.f, 0.f, 0.f, 0.f};
    h16x8 At[4][2], B0[2][2], B1[2][2];
    const char* cA = (const char*)g.A + (size_t)cur.pm * tstep; const char* cB = (const char*)g.Bt + (size_t)cur.pn * tstep;
    S.a_ready(cur);
    if constexpr (SP2) {
        PG8_STAGE(PG8_SB(0, 0), cB, voffB); PG8_STAGE(PG8_SB(0, 1), cB + hstep, voffB); PG8_STAGE(PG8_SA(0, 0), cA, voffA); PG8_STAGE(PG8_SA(0, 1), cA + hstep, voffA);
        if (wr == 1) PG8_BAR;
        PG8_WAIT_V(2); PG8_BAR;
        PG8_STAGE(PG8_SB(1, 0), cB + kstep, voffB); PG8_STAGE(PG8_SA(1, 0), cA + kstep, voffA); PG8_STAGE(PG8_SB(1, 1), cB + hstep + kstep, voffB);
        PG8_WAIT_V(6); PG8_BAR;
    } else {
        PG8_STAGE(PG8_SB(0, 0), cB, voffB); PG8_STAGE(PG8_SA(0, 0), cA, voffA); PG8_STAGE(PG8_SB(0, 1), cB + hstep, voffB); PG8_STAGE(PG8_SA(0, 1), cA + hstep, voffA);
        if (wr == 1) PG8_BAR;
        PG8_WAIT_V(4); PG8_BAR;
        PG8_STAGE(PG8_SB(1, 0), cB + kstep, voffB); PG8_STAGE(PG8_SA(1, 0), cA + kstep, voffA); PG8_STAGE(PG8_SB(1, 1), cB + hstep + kstep, voffB);
        PG8_WAIT_V(6); PG8_BAR;
    }
    for (;;) {
        const bool has_next = S.next(ui + 1, nxt);
        const char* nA = has_next ? (const char*)g.A + (size_t)nxt.pm * tstep : cA; const char* nB = has_next ? (const char*)g.Bt + (size_t)nxt.pn * tstep : cB;
        for (int t = 0; t < nt; t += 2) {
            const bool last = (t == nt - 2);
            const char* a1 = cA + (size_t)(t + 1) * kstep;
            const char* a2 = last ? nA : cA + (size_t)(t + 2) * kstep; const char* b2 = last ? nB : cB + (size_t)(t + 2) * kstep;
            const char* a3 = a2 + kstep; const char* b3 = b2 + kstep;
            if (last && has_next) S.a_ready(nxt);
            if constexpr (SP2) {
            PG8_LDB(B0, 0, 0); PG8_LDB(B1, 0, 1); PG8_SCHED; PG8_LDA(At, 0, 0); PG8_STAGE(PG8_SA(1, 1), a1 + hstep, voffA);
            PG8_WAIT_V(8); PG8_WAIT_L(0); PG8_BAR; PG8_MMA(0, 0, At, B0); PG8_MMA(0, 1, At, B1); PG8_BAR; PG8_SCHED;
            PG8_LDA(At, 0, 1); PG8_STAGE(PG8_SB(0, 0), b2, voffB); PG8_STAGE(PG8_SB(0, 1), b2 + hstep, voffB); PG8_STAGE(PG8_SA(0, 0), a2, voffA);
            PG8_WAIT_V(8); PG8_WAIT_L(0); PG8_BAR; PG8_MMA(1, 0, At, B0); PG8_MMA(1, 1, At, B1); PG8_BAR; PG8_SCHED;
            PG8_LDB(B0, 1, 0); PG8_LDB(B1, 1, 1); PG8_SCHED; PG8_LDA(At, 1, 0); PG8_STAGE(PG8_SA(0, 1), a2 + hstep, voffA);
            PG8_WAIT_V(8); PG8_WAIT_L(0); PG8_BAR; PG8_MMA(0, 0, At, B0); PG8_MMA(0, 1, At, B1); PG8_BAR; PG8_SCHED;
            PG8_LDA(At, 1, 1); PG8_STAGE(PG8_SB(1, 0), b3, voffB); PG8_STAGE(PG8_SB(1, 1), b3 + hstep, voffB); PG8_STAGE(PG8_SA(1, 0), a3, voffA);
            PG8_WAIT_V(8); PG8_WAIT_L(0); PG8_BAR; PG8_MMA(1, 0, At, B0); PG8_MMA(1, 1, At, B1); PG8_BAR; PG8_SCHED;
            } else {
            PG8_LDB(B0, 0, 0); PG8_SCHED; PG8_LDA(At, 0, 0); PG8_STAGE(PG8_SA(1, 1), a1 + hstep, voffA);
            PG8_WAIT_L(8); PG8_BAR; PG8_WAIT_L(0); PG8_MMA(0, 0, At, B0); PG8_BAR; PG8_SCHED;
            PG8_LDB(B1, 0, 1); PG8_STAGE(PG8_SB(0, 0), b2, voffB);
            PG8_BAR; PG8_WAIT_L(0); PG8_MMA(0, 1, At, B1); PG8_BAR;
            PG8_LDA(At, 0, 1); PG8_STAGE(PG8_SA(0, 0), a2, voffA);
            PG8_BAR; PG8_WAIT_L(0); PG8_MMA(1, 0, At, B0); PG8_BAR; PG8_SCHED;
            PG8_STAGE(PG8_SB(0, 1), b2 + hstep, voffB);
            PG8_WAIT_V(6); PG8_BAR; PG8_MMA(1, 1, At, B1); PG8_BAR;
            PG8_LDB(B0, 1, 0); PG8_SCHED; PG8_LDA(At, 1, 0); PG8_STAGE(PG8_SA(0, 1), a2 + hstep, voffA);
            PG8_WAIT_L(8); PG8_BAR; PG8_WAIT_L(0); PG8_MMA(0, 0, At, B0); PG8_BAR; PG8_SCHED;
            PG8_LDB(B1, 1, 1); PG8_STAGE(PG8_SB(1, 0), b3, voffB);
            PG8_BAR; PG8_WAIT_L(0); PG8_MMA(0, 1, At, B1); PG8_BAR;
            PG8_LDA(At, 1, 1); PG8_STAGE(PG8_SA(1, 0), a3, voffA);
            PG8_BAR; PG8_WAIT_L(0); PG8_MMA(1, 0, At, B0); PG8_BAR; PG8_SCHED;
            PG8_STAGE(PG8_SB(1, 1), b3 + hstep, voffB);
            PG8_WAIT_V(6); PG8_BAR; PG8_MMA(1, 1, At, B1); PG8_BAR;
            }
        }
        if constexpr (ALIGN_EPI) { if (wr == 0) PG8_BAR; }
        if constexpr (!Epi::AFTER_DRAIN) { E(acc, cur, wr, wc, fr, fq); S.done(cur); }
        if (!has_next) break;
#pragma unroll
        for (int a = 0; a < 2; ++a)
#pragma unroll
            for (int b = 0; b < 2; ++b)
#pragma unroll
                for (int m = 0; m < 4; ++m)
#pragma unroll
                    for (int n = 0; n < 2; ++n) acc[a][b][m][n] = (f32x4){0.f, 0.f, 0.f, 0.f};
        cur = nxt; cA = nA; cB = nB; ++ui;
        if constexpr (ALIGN_EPI) { if (wr == 1) PG8_BAR; }
    }
    PG8_WAIT_V(0);
    if constexpr (!ALIGN_EPI) { if (wr == 0) PG8_BAR; }
    PG8_BAR;
#undef PG8_SA
#undef PG8_SB
#undef PG8_STAGE
#undef PG8_LDA
#undef PG8_LDB
#undef PG8_MMA
#undef PG8_WAIT_V
#undef PG8_WAIT_L
#undef PG8_BAR
#undef PG8_SCHED
}
}

struct EpiGate {
    static constexpr bool PERM = false, AFTER_DRAIN = false;
    h16_t* cu; h16_t* bsz;
    __device__ __forceinline__ void operator()(const f32x4 (&acc)[2][2][4][2], const pg8::Unit& u, int wr, int wc, int fr, int fq) const {
        const int row0 = u.pm * 256 + wr * 64 + fr, ch0 = u.pn * 64 + wc * 16 + fq * 4;
#pragma unroll
        for (int ai = 0; ai < 2; ++ai)
#pragma unroll
            for (int m = 0; m < 4; ++m) {
                const size_t off = (size_t)(row0 + ai * 128 + m * 16) * CONV_D + ch0;
                const f32x4 b = acc[ai][0][m][0], c = acc[ai][0][m][1], uu = acc[ai][1][m][0], z = acc[ai][1][m][1];
                const f32x4 cv = c * uu;
                f32x4 sv;
#pragma unroll
                for (int e = 0; e < 4; ++e) sv[e] = b[e] * silu_f(z[e]);
                u32x2 w0, w1; w0.x = pk2h(cv[0], cv[1]); w0.y = pk2h(cv[2], cv[3]); w1.x = pk2h(sv[0], sv[1]); w1.y = pk2h(sv[2], sv[3]);
                *(u32x2*)(cu + off) = w0; *(u32x2*)(bsz + off) = w1;
            }
    }
};
template <bool WB> struct EpiRes {
    static constexpr bool PERM = false, AFTER_DRAIN = false;
    const float* res; float* out; h16_t* hb; float* ss;
    __device__ __forceinline__ void operator()(const f32x4 (&acc)[2][2][4][2], const pg8::Unit& u, int wr, int wc, int fr, int fq) const {
        const int row0 = u.pm * 256 + wr * 64 + fr, col0 = u.pn * 256 + wc * 32 + 4 * fq;
#pragma unroll
        for (int ai = 0; ai < 2; ++ai)
#pragma unroll
            for (int m = 0; m < 4; ++m) {
                const int row = row0 + ai * 128 + m * 16; const size_t off = (size_t)row * D_MODEL + col0; float s = 0.f;
#pragma unroll
                for (int bj = 0; bj < 2; ++bj)
#pragma unroll
                    for (int n = 0; n < 2; ++n) {
                        const size_t o2 = off + bj * 128 + n * 16;
                        const f32x4 h = *(const f32x4*)(res + o2) + acc[ai][bj][m][n];
                        *(f32x4*)(out + o2) = h;
                        if (WB) { u32x2 w; w.x = pk2h(h[0], h[1]); w.y = pk2h(h[2], h[3]); *(u32x2*)(hb + o2) = w; }
                        s += (h[0] * h[0] + h[1] * h[1]) + (h[2] * h[2] + h[3] * h[3]);
                    }
                s += __shfl_xor(s, 16); s += __shfl_xor(s, 32);
                if (fq == 0) ss[(size_t)row * 16 + u.pn * 4 + wc] = s;
            }
    }
};
struct EpiQKV {
    static constexpr bool PERM = false, AFTER_DRAIN = false;
    const float* ss1; const float* rope; h16_t* kv; h16_t* q; h16_t* qrot; h16_t* sz; float* gates;
    __device__ __forceinline__ void operator()(const f32x4 (&acc)[2][2][4][2], const pg8::Unit& u, int wr, int wc, int fr, int fq) const {
        const int row0 = u.pm * 256 + wr * 64 + fr; const int pn = u.pn;
#pragma unroll
        for (int ai = 0; ai < 2; ++ai)
#pragma unroll
            for (int m = 0; m < 4; ++m) {
                const int row = row0 + ai * 128 + m * 16, t = row & (SEQ - 1), b = row >> 12;
                const f32x4 pp = *(const f32x4*)(ss1 + (size_t)row * 16 + fq * 4);
                float s = (pp[0] + pp[1]) + (pp[2] + pp[3]); s += __shfl_xor(s, 16); s += __shfl_xor(s, 32);
                const float rs = rsqrtf(s * (1.0f / D_MODEL) + EPS);
                const f32x4 rc = *(const f32x4*)(rope + (size_t)t * 16 + 4 * (fq & 1)), rsn = *(const f32x4*)(rope + (size_t)t * 16 + 8 + 4 * (fq & 1));
#pragma unroll
                for (int bj = 0; bj < 2; ++bj)
#pragma unroll
                    for (int n = 0; n < 2; ++n) {
                        const int col = bj * 128 + wc * 32 + n * 16 + 4 * fq;
                        f32x4 v = acc[ai][bj][m][n] * rs;
                        if (pn < 10) {
                            const bool isq = pn >= 6;
                            if (isq) v = v * C2Q;
                            f32x4 vr = v;
                            if (n == 0 && (wc & 1) == 0) {
                                f32x4 pv;
#pragma unroll
                                for (int e = 0; e < 4; ++e) pv[e] = __shfl_xor(v[e], 32);
                                if (fq < 2) vr = v * rc - pv * rsn; else vr = v * rc + pv * rsn;
                            }
                            if (!isq) {
                                const int g = col >> 6, d = col & 63;
                                const bool roped = (pn == 2) || (pn == 4);
                                const f32x4 o = roped ? vr : v;
                                u32x2 w; w.x = pk2h(o[0], o[1]); w.y = pk2h(o[2], o[3]);
                                const size_t base = (((size_t)pn * 4 + b) * 4 + g) * (size_t)(SEQ * 64);
                                size_t off;
                                if (pn < 2) off = base + (size_t)t * 64 + d;
                                else if (pn & 1) off = base + (size_t)(t >> 6) * 4096 + vimg_off(t & 63, d);
                                else off = base + (size_t)(t >> 6) * 4096 + kimg_off(t & 63, d);
                                *(u32x2*)(kv + off) = w;
                            } else {
                                const size_t o2 = (size_t)row * D_MODEL + (pn - 6) * 256 + col;
                                u32x2 w; w.x = pk2h(v[0], v[1]); w.y = pk2h(v[2], v[3]); *(u32x2*)(q + o2) = w;
                                u32x2 w2; w2.x = pk2h(vr[0], vr[1]); w2.y = pk2h(vr[2], vr[3]); *(u32x2*)(qrot + o2) = w2;
                            }
                        } else if (pn < 14) {
                            f32x4 o;
#pragma unroll
                            for (int e = 0; e < 4; ++e) o[e] = silu_f(v[e]);
                            u32x2 w; w.x = pk2h(o[0], o[1]); w.y = pk2h(o[2], o[3]);
                            *(u32x2*)(sz + (size_t)row * D_MODEL + (pn - 10) * 256 + col) = w;
                        } else {
                            if (col < 48) {
                                f32x4 o;
#pragma unroll
                                for (int e = 0; e < 4; ++e) o[e] = sigmoid_f(v[e]);
                                *(f32x4*)(gates + (size_t)row * 48 + col) = o;
                            }
                        }
                    }
            }
    }
};

#define XB_TMO      128
#define XB_XCNT(j)  (256  + 64 * (j))
#define XB_XSUB(j)  (1280 + 64 * (j))
#define XB_XGEN(j)  (2304 + 64 * (j))
#define XB_TOP      3328
#define XB_TOPGEN   3392
#define XCD_BAR_WORDS 3456
#define XB_SPIN_CAP (1u << 18)
__device__ __forceinline__ unsigned xb_ld(unsigned* p)              { return __hip_atomic_load(p, __ATOMIC_RELAXED, __HIP_MEMORY_SCOPE_AGENT); }
__device__ __forceinline__ unsigned xb_add(unsigned* p, unsigned v) { return __hip_atomic_fetch_add(p, v, __ATOMIC_RELAXED, __HIP_MEMORY_SCOPE_AGENT); }
__device__ __forceinline__ unsigned xb_xcc_id() { return (unsigned)__builtin_amdgcn_s_getreg((3 << 11) | 20) & 0xFu; }
#define XB_SPIN(cond, bar) do { unsigned _sp = 0; while (cond) { __builtin_amdgcn_s_sleep(1); \
    if ((++_sp & 255u) == 0u) { if (xb_ld(&(bar)[XB_TMO])) break; if (_sp > XB_SPIN_CAP) { atomicAdd(&(bar)[XB_TMO], 1u); break; } } } } while (0)
struct XcdBarrier { unsigned* bar; unsigned x; volatile LAS unsigned* st; };
__device__ __forceinline__ XcdBarrier xcd_barrier_post(unsigned* bar, volatile LAS unsigned* st) {
    XcdBarrier b; b.bar = bar; b.x = xb_xcc_id(); b.st = st;
    if (threadIdx.x == 0) (void)xb_add(&bar[XB_XCNT(b.x)], 1u);
    return b;
}
__device__ __forceinline__ void xcd_barrier_complete(unsigned* bar, unsigned x, unsigned& nloc, unsigned& nx) {
    const unsigned G = gridDim.x * gridDim.y * gridDim.z;
    unsigned sum, cnt, mine, sp = 0u;
    for (;;) {
        sum = 0u; cnt = 0u; mine = 0u;
#pragma unroll
        for (unsigned j = 0; j < 16; ++j) { const unsigned c = xb_ld(&bar[XB_XCNT(j)]); sum += c; cnt += (c > 0u) ? 1u : 0u; mine = (j == x) ? c : mine; }
        if (sum == G) break;
        __builtin_amdgcn_s_sleep(1);
        if ((++sp & 255u) == 0u) { if (xb_ld(&bar[XB_TMO])) break; if (sp > XB_SPIN_CAP) { atomicAdd(&bar[XB_TMO], 1u); break; } }
    }
    nloc = mine > 0u ? mine : 1u; nx = cnt > 0u ? cnt : 1u;
}
__device__ __forceinline__ void xcd_barrier(const XcdBarrier& b) {
    asm volatile("s_waitcnt vmcnt(0)" ::: "memory");
    __syncthreads();
    if (threadIdx.x == 0) {
        unsigned* bar = b.bar;
        __builtin_amdgcn_s_waitcnt(0);
        unsigned nloc = b.st[0], nx = b.st[1];
        if (nloc == 0u) { xcd_barrier_complete(bar, b.x, nloc, nx); b.st[0] = nloc; b.st[1] = nx; }
        const unsigned old = xb_add(&bar[XB_XSUB(b.x)], 1u);
        const unsigned gen = old / nloc;
        if (old + 1u == (gen + 1u) * nloc) {
            __builtin_amdgcn_fence(__ATOMIC_RELEASE, "agent");
            asm volatile("s_waitcnt vmcnt(0)" ::: "memory");
            const unsigned og = xb_add(&bar[XB_TOP], 1u);
            const unsigned tg = og / nx;
            if (og + 1u == (tg + 1u) * nx) xb_add(&bar[XB_TOPGEN], 1u);
            else XB_SPIN(xb_ld(&bar[XB_TOPGEN]) == tg, bar);
            __builtin_amdgcn_fence(__ATOMIC_ACQUIRE, "agent");
            xb_add(&bar[XB_XGEN(b.x)], 1u);
            asm volatile("s_waitcnt vmcnt(0)" ::: "memory");
        } else {
            XB_SPIN(xb_ld(&bar[XB_XGEN(b.x)]) == gen, bar);
            __builtin_amdgcn_fence(__ATOMIC_ACQUIRE, "agent");
            asm volatile("s_waitcnt vmcnt(0)" ::: "memory");
        }
    }
    __syncthreads();
}

struct Params {
    const float* x; const float* a_norm; const float* a_w_in; const float* a_conv_w; const float* a_w_out;
    const float* kv_norm; const float* w_kv; const float* cmp_pos_k; const float* cmp_w1_k; const float* cmp_w2_k;
    const float* cmp_pos_v; const float* cmp_w1_v; const float* cmp_w2_v; const float* b_norm; const float* b_w_in; const float* b_w_out; const float* final_norm;
    float* out; unsigned char* ws;
};
struct Args { Params p; int ph_lo, ph_hi; };

__device__ __forceinline__ int w1_src_col(int r) { const int j = r >> 8, rho = r & 255; const int s = 2 * (rho >> 7) + ((rho >> 4) & 1); const int c64 = 16 * ((rho >> 5) & 3) + (rho & 15); return s * CONV_D + 64 * j + c64; }
__device__ __forceinline__ int w3b_src_col(int r) { if (r < 1024) return r; if (r < 2048) return 1072 + (r - 1024); if (r < 2096) return 1024 + (r - 2048); return -1; }
__device__ __forceinline__ void tr_item(const float* W, int K, int N, h16_t* dst, const float* gain, int mode, int item, int lane, int wave) {
    const int kblocks = K >> 6; const int rb = item / kblocks, kb = item % kblocks;
    const int r = rb * 64 + lane, k0 = kb * 64 + wave * 8;
    int sc = r; if (mode == 1) sc = w1_src_col(r); else if (mode == 2) sc = w3b_src_col(r);
    float v[8];
#pragma unroll
    for (int i = 0; i < 8; ++i) { float w = 0.f; if (sc >= 0) { w = W[(size_t)(k0 + i) * N + sc]; if (gain) w *= gain[k0 + i]; } v[i] = w; }
    u32x4 o; o.x = pk2h(v[0], v[1]); o.y = pk2h(v[2], v[3]); o.z = pk2h(v[4], v[5]); o.w = pk2h(v[6], v[7]);
    *(u32x4*)(dst + (size_t)r * K + k0) = o;
}
__device__ __forceinline__ void phase_prologue(const Params& p, int tid, int lane, int wave, int bid, int G) {
    unsigned char* ws = p.ws;
    constexpr int I0 = 128 * 16, I1 = 16 * 32, I2 = 24 * 16, I3 = 36 * 16, I4 = 16 * 16, I5 = 4 * 32, I6 = 4 * 32, I7 = 4, I8 = 4;
    constexpr int NIT = I0 + I1 + I2 + I3 + I4 + I5 + I6 + I7 + I8;
    for (int it = bid; it < NIT; it += G) {
        int r = it;
        if (r < I0) { tr_item(p.a_w_in, 1024, 8192, (h16_t*)(ws + WS_W1T), p.a_norm, 1, r, lane, wave); continue; } r -= I0;
        if (r < I1) { tr_item(p.a_w_out, 2048, 1024, (h16_t*)(ws + WS_W2T), nullptr, 0, r, lane, wave); continue; } r -= I1;
        if (r < I2) { tr_item(p.w_kv, 1024, 1536, (h16_t*)(ws + WS_W3T), p.kv_norm, 0, r, lane, wave); continue; } r -= I2;
        if (r < I3) { tr_item(p.b_w_in, 1024, 2096, (h16_t*)(ws + WS_W3T) + (size_t)1536 * 1024, p.b_norm, 2, r, lane, wave); continue; } r -= I3;
        if (r < I4) { tr_item(p.b_w_out, 1024, 1024, (h16_t*)(ws + WS_W4T), nullptr, 0, r, lane, wave); continue; } r -= I4;
        if (r < I5) { tr_item(p.cmp_w1_k, 2048, 256, (h16_t*)(ws + WS_CW1K), nullptr, 0, r, lane, wave); continue; } r -= I5;
        if (r < I6) { tr_item(p.cmp_w1_v, 2048, 256, (h16_t*)(ws + WS_CW1V), nullptr, 0, r, lane, wave); continue; } r -= I6;
        if (r < I7) { tr_item(p.cmp_w2_k, 256, 64, (h16_t*)(ws + WS_CW2K), nullptr, 0, r, lane, wave); continue; } r -= I7;
        tr_item(p.cmp_w2_v, 256, 64, (h16_t*)(ws + WS_CW2V), nullptr, 0, r, lane, wave);
    }
    const int gw = bid * NWAVES + wave, NGW = G * NWAVES;
    for (int m = gw; m < M_ROWS; m += NGW) {
        const f32x4* xr = (const f32x4*)(p.x + (size_t)m * D_MODEL) + lane;
        f32x4 v[4]; float s = 0.f;
#pragma unroll
        for (int j = 0; j < 4; ++j) { v[j] = xr[64 * j]; s += (v[j][0] * v[j][0] + v[j][1] * v[j][1]) + (v[j][2] * v[j][2] + v[j][3] * v[j][3]); }
        const float rs = rsqrtf(wave_sum(s) * (1.0f / D_MODEL) + EPS);
        u32x2* o8 = (u32x2*)((h16_t*)(ws + WS_XN) + (size_t)m * D_MODEL) + lane;
#pragma unroll
        for (int j = 0; j < 4; ++j) { u32x2 w; w.x = pk2h(v[j][0] * rs, v[j][1] * rs); w.y = pk2h(v[j][2] * rs, v[j][3] * rs); o8[64 * j] = w; }
    }
    const int gt = bid * NTHREADS + tid, NGT = G * NTHREADS;
    float* rope = (float*)(ws + WS_ROPE);
    for (int i = gt; i < SEQ * 8; i += NGT) {
        const int t = i >> 3, f = i & 7;
        const float inv = powf(500000.0f, -(float)f * 0.125f);
        const float ang = (float)t * inv;
        rope[t * 16 + f] = cosf(ang); rope[t * 16 + 8 + f] = sinf(ang);
    }
    h16_t* wimp = (h16_t*)(ws + WS_WIMP);
    for (int i = gt; i < 4 * 4096; i += NGT) {
        const int T = i >> 12, keyl = (i >> 6) & 63, j = i & 63, n = 64 * T + keyl;
        const float w = ((n == 4 * j - 1) ? 1.f : 0.f) + ((n >= 4 * j && n <= 4 * j + 2) ? 2.f : 0.f) + ((n == 4 * j + 3) ? 1.f : 0.f);
        wimp[T * 4096 + vimg_off(keyl, j)] = f2h(w);
    }
    float* cbp = (float*)(ws + WS_CBP);
    for (int it = bid; it < 64; it += G) {
        const int which = it >> 5, sl = it & 31;
        const float* pos = which ? p.cmp_pos_v : p.cmp_pos_k; const float* w1 = which ? p.cmp_w1_v : p.cmp_w1_k;
        if (tid < 256) { float a = 0.f;
            for (int k = 0; k < 64; ++k) a += pos[sl * 64 + k] * w1[(size_t)(sl * 64 + k) * 256 + tid];
            cbp[(which * 32 + sl) * 256 + tid] = a; }
    }
}

__device__ __forceinline__ void phase_conv(const Params& p, int tid, int bid, int G) {
    const h16_t* cu = (const h16_t*)(p.ws + WS_CU); h16_t* bsz = (h16_t*)(p.ws + WS_BSZ);
    const int gt = bid * NTHREADS + tid, NGT = G * NTHREADS;
    for (int it = gt; it < (M_ROWS / 16) * 256; it += NGT) {
        const int chunk = it & 255, strip = it >> 8; const int r0 = strip * 16, ch = chunk * 8;
        float w0[8], w1[8], w2[8], p1[8], p2[8];
#pragma unroll
        for (int e = 0; e < 8; ++e) { w0[e] = p.a_conv_w[ch + e]; w1[e] = p.a_conv_w[CONV_D + ch + e]; w2[e] = p.a_conv_w[2 * CONV_D + ch + e]; p1[e] = 0.f; p2[e] = 0.f; }
        if ((r0 & (SEQ - 1)) != 0) {
            const u32x4 a = *(const u32x4*)(cu + (size_t)(r0 - 2) * CONV_D + ch), b = *(const u32x4*)(cu + (size_t)(r0 - 1) * CONV_D + ch);
#pragma unroll
            for (int e = 0; e < 4; ++e) { p2[2 * e] = h_lo(a[e]); p2[2 * e + 1] = h_hi(a[e]); p1[2 * e] = h_lo(b[e]); p1[2 * e + 1] = h_hi(b[e]); }
        }
        for (int r = r0; r < r0 + 16; ++r) {
            const u32x4 cw = *(const u32x4*)(cu + (size_t)r * CONV_D + ch), sw = *(const u32x4*)(bsz + (size_t)r * CONV_D + ch);
            float c[8], sv[8], y[8];
#pragma unroll
            for (int e = 0; e < 4; ++e) { c[2 * e] = h_lo(cw[e]); c[2 * e + 1] = h_hi(cw[e]); sv[2 * e] = h_lo(sw[e]); sv[2 * e + 1] = h_hi(sw[e]); }
#pragma unroll
            for (int e = 0; e < 8; ++e) { y[e] = sv[e] * (w0[e] * p2[e] + w1[e] * p1[e] + w2[e] * c[e]); p2[e] = p1[e]; p1[e] = c[e]; }
            u32x4 o; o.x = pk2h(y[0], y[1]); o.y = pk2h(y[2], y[3]); o.z = pk2h(y[4], y[5]); o.w = pk2h(y[6], y[7]);
            *(u32x4*)(bsz + (size_t)r * CONV_D + ch) = o;
        }
    }
}

__device__ __forceinline__ void phase_compress(const Params& p, LAS unsigned char* lds, int lane, int wave, int bid, int G) {
    const int r = lane & 31, h = lane >> 5;
    LAS h16_t* hs = (LAS h16_t*)lds;
    for (int it = bid; it < 256; it += G) {
        const int which = it >> 7, bg = (it >> 3) & 15, rt = it & 7, n0 = rt * 32;
        const h16_t* kc = (const h16_t*)(p.ws + WS_KV) + (size_t)which * (16 * SEQ * 64) + (size_t)bg * SEQ * 64;
        const h16_t* w1t = (const h16_t*)(p.ws + (which ? WS_CW1V : WS_CW1K));
        const h16_t* w2t = (const h16_t*)(p.ws + (which ? WS_CW2V : WS_CW2K));
        const float* cbp = (const float*)(p.ws + WS_CBP) + which * 32 * 256;
        h16_t* outp = (h16_t*)(p.ws + (which ? WS_VCMP : WS_KCMP)) + (size_t)bg * 256 * 64;
        {
            f32x16 acc;
#pragma unroll
            for (int i = 0; i < 16; ++i) acc[i] = 0.f;
            asm volatile("" : "+v"(acc));
            const h16_t* arow = kc + (size_t)(n0 + r) * 1024 + 8 * h;
            const h16_t* brow = w1t + (size_t)(32 * wave + r) * 2048 + 8 * h;
#pragma unroll 8
            for (int s = 0; s < 128; ++s) {
                const h16x8 a = *(const h16x8*)(arow + 16 * s), b = *(const h16x8*)(brow + 16 * s);
                acc = MFMA32(a, b, acc);
            }
            const int col = 32 * wave + r; float bias = 0.f;
            for (int s = 0; s < 32; ++s) bias += cbp[s * 256 + col];
#pragma unroll
            for (int i = 0; i < 16; ++i) { const int row = (i & 3) + 8 * (i >> 2) + 4 * h; const float g = gelu_tanh_f(acc[i] + bias);
                hs[row * 256 + col] = f2h(g); }
        }
        __syncthreads();
        if (wave < 2) {
            f32x16 o;
#pragma unroll
            for (int i = 0; i < 16; ++i) o[i] = 0.f;
            asm volatile("" : "+v"(o));
#pragma unroll
            for (int s = 0; s < 16; ++s) {
                const h16x8 a = *(const LAS h16x8*)(hs + r * 256 + 16 * s + 8 * h);
                const h16x8 b = *(const h16x8*)(w2t + (size_t)(32 * wave + r) * 256 + 16 * s + 8 * h);
                o = MFMA32(a, b, o);
            }
#pragma unroll
            for (int i = 0; i < 16; ++i) { const int row = (i & 3) + 8 * (i >> 2) + 4 * h; const int n = n0 + row;
                const int cc = 32 * wave + r;
                outp[(size_t)(n >> 6) * 4096 + (which ? vimg_off(n & 63, cc) : kimg_off(n & 63, cc))] = (n < 255) ? f2h(o[i]) : (h16_t)0; }
        }
        __syncthreads();
    }
}

namespace fa {
constexpr int TILE = 8192, BUF = 3 * TILE;
constexpr int OFF_IMP = 2 * BUF, OFF_SEL = OFF_IMP + 16384, OFF_WSF = OFF_SEL + 512, OFF_GATE = OFF_WSF + 8 * 512, OFF_TOT = OFF_GATE + 8 * 512, END = OFF_TOT + 8 * 8192;
static_assert(END <= LDSCTL_OFF, "attention LDS map");
constexpr float THR = 8.0f;
typedef short v4i16 __attribute__((ext_vector_type(4)));
__device__ __forceinline__ int crow(int r, int hi) { return (r & 3) + 8 * (r >> 2) + 4 * hi; }
__device__ __forceinline__ float swap_max(float v) { auto rr = __builtin_amdgcn_permlane32_swap(__float_as_uint(v), __float_as_uint(v), false, false); return fmaxf(__uint_as_float(rr[0]), __uint_as_float(rr[1])); }
__device__ __forceinline__ float swap_sum(float v) { auto rr = __builtin_amdgcn_permlane32_swap(__float_as_uint(v), __float_as_uint(v), false, false); return __uint_as_float(rr[0]) + __uint_as_float(rr[1]); }
__device__ __forceinline__ h16x8 vfrag(const LAS unsigned char* p) {
    const v4i16 lo = __builtin_amdgcn_ds_read_tr16_b64_v4i16((LAS v4i16*)p), hh = __builtin_amdgcn_ds_read_tr16_b64_v4i16((LAS v4i16*)(p + 512));
    return (h16x8){lo[0], lo[1], lo[2], lo[3], hh[0], hh[1], hh[2], hh[3]};
}
#define FA_WAITBAR() asm volatile("s_waitcnt vmcnt(0) lgkmcnt(0)\n\ts_barrier" ::: "memory")
template <bool IMP>
__device__ __forceinline__ void tile_step(const LAS unsigned char* kimg, const LAS unsigned char* vimg, const LAS unsigned char* wimg,
                                          const h16x8& q0, const h16x8& q1, const h16x8& q2, const h16x8& q3,
                                          f32x16& o0, f32x16& o1, f32x16& oi0, f32x16& oi1, f32x16& negm, float& m, float& l, bool& seen,
                                          int klo, int khi, bool need_mask, LAS float* wsf, int lane) {
    const int r32 = lane & 31, hi = lane >> 5;
    const LAS unsigned char* kb = kimg + hi * 1024 + r32 * 16;
    f32x16 p0 = negm, p1 = negm;
    p0 = MFMA32(*(const LAS h16x8*)(kb), q0, p0);        p1 = MFMA32(*(const LAS h16x8*)(kb + 512), q0, p1);  __builtin_amdgcn_sched_barrier(0);
    p0 = MFMA32(*(const LAS h16x8*)(kb + 2048), q1, p0); p1 = MFMA32(*(const LAS h16x8*)(kb + 2560), q1, p1); __builtin_amdgcn_sched_barrier(0);
    p0 = MFMA32(*(const LAS h16x8*)(kb + 4096), q2, p0); p1 = MFMA32(*(const LAS h16x8*)(kb + 4608), q2, p1); __builtin_amdgcn_sched_barrier(0);
    p0 = MFMA32(*(const LAS h16x8*)(kb + 6144), q3, p0); p1 = MFMA32(*(const LAS h16x8*)(kb + 6656), q3, p1);
    __builtin_amdgcn_sched_barrier(0);
    if (need_mask) {
#pragma unroll
        for (int r = 0; r < 16; ++r) { const int k0 = crow(r, hi);
            if (k0 <= klo || k0 > khi) p0[r] = -INFINITY;
            if (k0 + 32 <= klo || k0 + 32 > khi) p1[r] = -INFINITY; }
    }
    float rm = fmaxf(p0[0], p1[0]);
#pragma unroll
    for (int r = 1; r < 16; ++r) rm = fmaxf(rm, fmaxf(p0[r], p1[r]));
    rm = swap_max(rm);
    const bool fin = rm > -INFINITY;
    const bool need = (rm > THR) || (!seen && fin);
    if (__any(need)) {
        const float delta = need ? rm : 0.f;
        const float alpha = (need && seen) ? __builtin_amdgcn_exp2f(-delta) : 1.f;
        m += delta; l *= alpha;
#pragma unroll
        for (int r = 0; r < 16; ++r) { p0[r] -= delta; p1[r] -= delta; negm[r] = -m; }
        if (hi == 0) wsf[r32] = alpha;
        int h4 = 4 * hi; asm volatile("" : "+v"(h4)); const LAS float* wb = wsf + h4;
#pragma unroll
        for (int a = 0; a < 4; ++a) { const f32x4 al = *(const LAS f32x4*)(wb + 8 * a);
#pragma unroll
            for (int bb = 0; bb < 4; ++bb) { o0[4 * a + bb] *= al[bb]; o1[4 * a + bb] *= al[bb]; if (IMP) { oi0[4 * a + bb] *= al[bb]; oi1[4 * a + bb] *= al[bb]; } } }
    }
    seen = seen || fin;
    float sacc = 0.f;
#pragma unroll
    for (int r = 0; r < 16; ++r) { p0[r] = __builtin_amdgcn_exp2f(p0[r]); p1[r] = __builtin_amdgcn_exp2f(p1[r]); sacc += p0[r] + p1[r]; }
    l += sacc;
    u32x4 pw0, pw1, pw2, pw3;
    pw0.x = pk2h(p0[0], p0[1]); pw0.y = pk2h(p0[2], p0[3]); pw0.z = pk2h(p0[4], p0[5]); pw0.w = pk2h(p0[6], p0[7]);
    pw1.x = pk2h(p0[8], p0[9]); pw1.y = pk2h(p0[10], p0[11]); pw1.z = pk2h(p0[12], p0[13]); pw1.w = pk2h(p0[14], p0[15]);
    pw2.x = pk2h(p1[0], p1[1]); pw2.y = pk2h(p1[2], p1[3]); pw2.z = pk2h(p1[4], p1[5]); pw2.w = pk2h(p1[6], p1[7]);
    pw3.x = pk2h(p1[8], p1[9]); pw3.y = pk2h(p1[10], p1[11]); pw3.z = pk2h(p1[12], p1[13]); pw3.w = pk2h(p1[14], p1[15]);
    const int voff = ((lane >> 4) & 1) * 32 + (lane & 3) * 8 + (4 * hi + ((lane & 15) >> 2)) * 64;
#define FA_SB() __builtin_amdgcn_sched_barrier(0)
    { const LAS unsigned char* vp = vimg + voff;
      FA_SB(); o0 = MFMA32(pw0, vfrag(vp), o0);        o1 = MFMA32(pw0, vfrag(vp + 4096), o1);
      FA_SB(); o0 = MFMA32(pw1, vfrag(vp + 1024), o0); o1 = MFMA32(pw1, vfrag(vp + 4096 + 1024), o1);
      FA_SB(); o0 = MFMA32(pw2, vfrag(vp + 2048), o0); o1 = MFMA32(pw2, vfrag(vp + 4096 + 2048), o1);
      FA_SB(); o0 = MFMA32(pw3, vfrag(vp + 3072), o0); o1 = MFMA32(pw3, vfrag(vp + 4096 + 3072), o1); FA_SB(); }
    if (IMP) { const LAS unsigned char* wp = wimg + voff;
      oi0 = MFMA32(pw0, vfrag(wp), oi0);        oi1 = MFMA32(pw0, vfrag(wp + 4096), oi1);
      FA_SB(); oi0 = MFMA32(pw1, vfrag(wp + 1024), oi0); oi1 = MFMA32(pw1, vfrag(wp + 4096 + 1024), oi1);
      FA_SB(); oi0 = MFMA32(pw2, vfrag(wp + 2048), oi0); oi1 = MFMA32(pw2, vfrag(wp + 4096 + 2048), oi1);
      FA_SB(); oi0 = MFMA32(pw3, vfrag(wp + 3072), oi0); oi1 = MFMA32(pw3, vfrag(wp + 4096 + 3072), oi1); FA_SB(); }
}
__device__ __forceinline__ void zero16(f32x16& v) {
#pragma unroll
    for (int i = 0; i < 16; ++i) v[i] = 0.f;
    asm volatile("" : "+v"(v));
}
__device__ __forceinline__ void issue_tile(LAS unsigned char* lds, int buf, const h16_t* kt, const h16_t* vt, const h16_t* wt, int lane, int wave) {
    LAS unsigned char* dst = lds + buf * BUF + wave * 1024;
    unsigned lo = (unsigned)(wave * 1024 + lane * 16); asm volatile("" : "+v"(lo));
    __builtin_amdgcn_global_load_lds((const unsigned*)((const char*)kt + lo), (LAS unsigned*)dst, 16, 0, 0);
    __builtin_amdgcn_global_load_lds((const unsigned*)((const char*)vt + lo), (LAS unsigned*)(dst + TILE), 16, 0, 0);
    if (wt) __builtin_amdgcn_global_load_lds((const unsigned*)((const char*)wt + lo), (LAS unsigned*)(dst + 2 * TILE), 16, 0, 0);
}
template <bool FIRST>
__device__ __forceinline__ void fold_branch(LAS float* tot, const f32x16& o0, const f32x16& o1, float fac, LAS float* wsf, int r32, int hi) {
    if (hi == 0) wsf[r32] = fac;
    int lo = hi * 256 + r32, h4 = 4 * hi; asm volatile("" : "+v"(lo), "+v"(h4));
    LAS float* tb = tot + lo; const LAS float* wb = wsf + h4;
#pragma unroll
    for (int a = 0; a < 4; ++a) { const f32x4 f = *(const LAS f32x4*)(wb + 8 * a);
#pragma unroll
        for (int bb = 0; bb < 4; ++bb) { LAS float* tp = tb + (8 * a + bb) * 64; const int r = 4 * a + bb;
            if (FIRST) { tp[0] = o0[r] * f[bb]; tp[32] = o1[r] * f[bb]; } else { tp[0] += o0[r] * f[bb]; tp[32] += o1[r] * f[bb]; } } }
}
__device__ __forceinline__ void attn_unit(const Params& p, LAS unsigned char* lds, int b, int g, int qb, int tid, int lane, int wave) {
    const int r32 = lane & 31, hi = lane >> 5, bg = b * 4 + g;
    const int tq = 8 * wave + (r32 >> 2), t = 64 * qb + tq;
    unsigned char* ws = p.ws;
    const h16_t* kvb = (const h16_t*)(ws + WS_KV); const size_t strm = (size_t)16 * SEQ * 64, bgoff = (size_t)bg * SEQ * 64;
    const h16_t* ks_img = kvb + 2 * strm + bgoff; const h16_t* vs_img = kvb + 3 * strm + bgoff; const h16_t* kw_img = kvb + 4 * strm + bgoff; const h16_t* vw_img = kvb + 5 * strm + bgoff;
    const h16_t* kc_img = (const h16_t*)(ws + WS_KCMP) + (size_t)bg * 16384; const h16_t* vc_img = (const h16_t*)(ws + WS_VCMP) + (size_t)bg * 16384;
    const h16_t* wimp = (const h16_t*)(ws + WS_WIMP);
    LAS float* S = (LAS float*)(lds + OFF_IMP); LAS unsigned* sel = (LAS unsigned*)(lds + OFF_SEL);
    LAS float* wsf = (LAS float*)(lds + OFF_WSF) + wave * 128; LAS float* gl = (LAS float*)(lds + OFF_GATE) + wave * 128;
    const size_t qoff = ((size_t)b * SEQ + t) * D_MODEL + (4 * g + (r32 & 3)) * 64 + 8 * hi;
    const h16_t* qp = (const h16_t*)(ws + WS_Q) + qoff; const h16_t* qrp = (const h16_t*)(ws + WS_QROT) + qoff;
    const h16x8 q1 = *(const h16x8*)(qp + 16), q2 = *(const h16x8*)(qp + 32), q3 = *(const h16x8*)(qp + 48);
    { const float* gsrc = (const float*)(ws + WS_GATES) + ((size_t)b * SEQ + 64 * qb + 8 * wave) * 48 + g * 12;
      for (int idx = lane; idx < 96; idx += 64) { const int ql = idx / 12, rem = idx - ql * 12; gl[idx] = gsrc[ql * 48 + rem]; } }
    LAS float* tot = (LAS float*)(lds + OFF_TOT) + wave * 2048;
    f32x16 o0, o1, oi0, oi1, negm;
    float m, l; bool seen;
    {
        const int nv = t >= 31 ? ((t - 31) >> 4) + 1 : 0;
        const int nct = (4 * qb + 66) >> 6;
        const h16x8 qc0 = *(const h16x8*)(qp);
        zero16(o0); zero16(o1); zero16(oi0); zero16(oi1); zero16(negm); m = 0.f; l = 0.f; seen = false;
        issue_tile(lds, 0, kc_img, vc_img, wimp, lane, wave);
        for (int T = 0; T < nct; ++T) {
            FA_WAITBAR();
            if (T + 1 < nct) issue_tile(lds, (T + 1) & 1, kc_img + (T + 1) * 4096, vc_img + (T + 1) * 4096, wimp + (T + 1) * 4096, lane, wave);
            const int khi = nv - 1 - 64 * T;
            if (__any(khi >= 0)) {
                const LAS unsigned char* bp = lds + (T & 1) * BUF;
                tile_step<true>(bp, bp + TILE, bp + 2 * TILE, qc0, q1, q2, q3, o0, o1, oi0, oi1, negm, m, l, seen, -1, khi, __any(khi < 63), wsf, lane);
            }
        }
        const float inv = 1.0f / fmaxf(swap_sum(l), 1e-30f);
        fold_branch<true>(tot, o0, o1, gl[3 * r32 + 0] * inv, wsf, r32, hi);
        if (hi == 0) wsf[32 + r32] = inv;
        { int h4 = 4 * hi, sb = (8 * wave + hi) * 64 + r32; asm volatile("" : "+v"(h4), "+v"(sb));
          const LAS float* wb = wsf + 32 + h4; LAS float* Sb = S + sb;
          const int j0 = r32, j1 = 32 + r32;
          const bool f0 = (j0 == 0 || j0 >= qb - 1), f1 = (j1 >= qb - 1);
#pragma unroll
          for (int a = 0; a < 4; ++a) { const f32x4 ia = *(const LAS f32x4*)(wb + 8 * a);
            const float v0 = (oi0[4 * a] * ia[0] + oi0[4 * a + 1] * ia[1]) + (oi0[4 * a + 2] * ia[2] + oi0[4 * a + 3] * ia[3]);
            const float v1 = (oi1[4 * a] * ia[0] + oi1[4 * a + 1] * ia[1]) + (oi1[4 * a + 2] * ia[2] + oi1[4 * a + 3] * ia[3]);
            Sb[2 * a * 64] = (j0 <= qb) ? (f0 ? 1e4f : v0) : -INFINITY;
            Sb[2 * a * 64 + 32] = (j1 <= qb) ? (f1 ? 1e4f : v1) : -INFINITY; } }
    }
    FA_WAITBAR();
    if (qb >= 16) {
        const int qq = tid >> 3, part = tid & 7; const LAS float* Sq = S + qq * 64;
        float sv[8]; int rk[8];
#pragma unroll
        for (int i = 0; i < 8; ++i) { sv[i] = Sq[part * 8 + i]; rk[i] = 0; }
        for (int k = 0; k < 64; ++k) { const float sk = Sq[k];
#pragma unroll
            for (int i = 0; i < 8; ++i) rk[i] += ((sk > sv[i]) || (sk == sv[i] && k < part * 8 + i)) ? 1 : 0; }
        unsigned bits = 0;
#pragma unroll
        for (int i = 0; i < 8; ++i) if (sv[i] > -INFINITY && rk[i] < 16) bits |= 1u << i;
        unsigned lo = (part < 4) ? (bits << (8 * part)) : 0u, hh = (part >= 4) ? (bits << (8 * (part - 4))) : 0u;
        lo |= __shfl_xor(lo, 1); lo |= __shfl_xor(lo, 2); lo |= __shfl_xor(lo, 4);
        hh |= __shfl_xor(hh, 1); hh |= __shfl_xor(hh, 2); hh |= __shfl_xor(hh, 4);
        if (part == 0) { sel[2 * qq] = lo; sel[2 * qq + 1] = hh; }
    } else {
        if (tid < 64) { sel[2 * tid] = (2u << qb) - 1u; sel[2 * tid + 1] = 0u; }
    }
    FA_WAITBAR();
    {
        const h16x8 qr0 = *(const h16x8*)(qrp);
        const unsigned long long smask = (unsigned long long)sel[2 * tq] | ((unsigned long long)sel[2 * tq + 1] << 32);
        const int n_slc = qb + 1, w0 = (qb >= 8) ? qb - 8 : 0, n_all = n_slc + (qb - w0 + 1);
        zero16(o0); zero16(o1); zero16(negm); m = 0.f; l = 0.f; seen = false;
        issue_tile(lds, 0, ks_img, vs_img, nullptr, lane, wave);
        for (int i = 0; i < n_all; ++i) {
            FA_WAITBAR();
            if (i + 1 < n_all) { const int i1 = i + 1;
                if (i1 < n_slc) issue_tile(lds, i1 & 1, ks_img + (size_t)i1 * 4096, vs_img + (size_t)i1 * 4096, nullptr, lane, wave);
                else { const int j1 = w0 + (i1 - n_slc); issue_tile(lds, i1 & 1, kw_img + (size_t)j1 * 4096, vw_img + (size_t)j1 * 4096, nullptr, lane, wave); } }
            const LAS unsigned char* bp = lds + (i & 1) * BUF;
            if (i < n_slc) {
                const int j = i; const bool sb = (smask >> j) & 1ull;
                const int khi = sb ? ((j == qb) ? tq : 63) : -1;
                if (__any(sb)) tile_step<false>(bp, bp + TILE, bp, qr0, q1, q2, q3, o0, o1, oi0, oi1, negm, m, l, seen, -1, khi, __any(khi < 63), wsf, lane);
            } else {
                if (i == n_slc) {
                    const float inv = 1.0f / fmaxf(swap_sum(l), 1e-30f);
                    fold_branch<false>(tot, o0, o1, gl[3 * r32 + 1] * inv, wsf, r32, hi);
                    zero16(o0); zero16(o1); zero16(negm); m = 0.f; l = 0.f; seen = false;
                }
                const int j = w0 + (i - n_slc);
                const int klo = (j == qb - 8) ? tq : -1, khi = (j == qb) ? tq : 63;
                tile_step<false>(bp, bp + TILE, bp, qr0, q1, q2, q3, o0, o1, oi0, oi1, negm, m, l, seen, klo, khi, (j == qb) || (j == qb - 8), wsf, lane);
            }
        }
        const float inv = 1.0f / fmaxf(swap_sum(l), 1e-30f);
        fold_branch<false>(tot, o0, o1, gl[3 * r32 + 2] * inv, wsf, r32, hi);
    }
    {
        int lo = hi * 256 + r32; asm volatile("" : "+v"(lo)); const LAS float* tb = tot + lo;
        const size_t ob = ((size_t)b * SEQ + 64 * qb + 8 * wave + hi) * D_MODEL + (4 * g) * 64 + r32;
        const h16_t* szb = (const h16_t*)(ws + WS_SZ) + ob; h16_t* y2 = (h16_t*)(ws + WS_XN) + ob;
#pragma unroll
        for (int a = 0; a < 4; ++a) {
#pragma unroll
            for (int bb = 0; bb < 4; ++bb) { const int o = 2 * a * D_MODEL + bb * 64; const LAS float* tp = tb + (8 * a + bb) * 64;
                y2[o] = f2h(tp[0] * h2f(szb[o])); y2[o + 32] = f2h(tp[32] * h2f(szb[o + 32])); } }
    }
    FA_WAITBAR();
}
__device__ __forceinline__ void phase_attn(const Params& p, LAS unsigned char* lds, int tid, int lane, int wave, int bid, int G) {
    for (int i = 0;; ++i) {
        const int L = i * G + bid; if (L >= 1024) break;
        int bgi, qb;
        if (G == 256) { const int vcu = (bid & 7) * 32 + (bid >> 3), s16 = vcu & 15; bgi = vcu >> 4; qb = (i == 0) ? 63 - s16 : (i == 1) ? 32 + s16 : (i == 2) ? 31 - s16 : s16; }
        else { bgi = L >> 6; qb = L & 63; }
        attn_unit(p, lds, bgi >> 2, bgi & 3, qb, tid, lane, wave);
    }
}
}

#ifndef ATTN_DEBUG
#define ATTN_DEBUG 0
#endif
#if ATTN_DEBUG
constexpr int NAIVE_WAVES = 6, NAIVE_F = 5648;
__device__ __forceinline__ void dot4(const h16_t* kbase, const LAS float* qv, float& a0, float& a1, float& a2, float& a3) {
    a0 = 0.f; a1 = 0.f; a2 = 0.f; a3 = 0.f;
#pragma unroll
    for (int c = 0; c < 8; ++c) {
        const u32x4 kk = *(const u32x4*)(kbase + c * 512);
#pragma unroll
        for (int e = 0; e < 4; ++e) {
            const float k0 = h_lo(kk[e]), k1 = h_hi(kk[e]); const int d = c * 8 + 2 * e;
            a0 += k0 * qv[d] + k1 * qv[d + 1]; a1 += k0 * qv[64 + d] + k1 * qv[64 + d + 1];
            a2 += k0 * qv[128 + d] + k1 * qv[128 + d + 1]; a3 += k0 * qv[192 + d] + k1 * qv[192 + d + 1];
        }
    }
}
__device__ __forceinline__ float softmax_row(LAS float* S, int cnt, int lane) {
    float m = -INFINITY;
    for (int k = lane; k < cnt; k += 64) m = fmaxf(m, S[k]);
    m = wave_max(m); if (!(m > -INFINITY)) m = 0.f;
    float sum = 0.f;
    for (int k = lane; k < cnt; k += 64) { const float s = S[k]; const float e = (s > -INFINITY) ? exp2f(s - m) : 0.f; S[k] = e; sum += e; }
    sum = wave_sum(sum);
    return 1.0f / fmaxf(sum, 1e-30f);
}
__device__ __forceinline__ void phase_attn_naive(const Params& p, LAS unsigned char* lds, int lane, int wave, int bid, int G) {
    if (wave >= NAIVE_WAVES) return;
    LAS float* L = (LAS float*)lds + wave * NAIVE_F;
    LAS float* qs = L; LAS float* qrs = L + 256; LAS float* pc = L + 512; LAS float* sc = L + 1536; LAS int* sel = (LAS int*)(L + 5632);
    const h16_t* qb = (const h16_t*)(p.ws + WS_Q); const h16_t* qrb = (const h16_t*)(p.ws + WS_QROT);
    const h16_t* kvb = (const h16_t*)(p.ws + WS_KV); const h16_t* szb = (const h16_t*)(p.ws + WS_SZ);
    const float* gates = (const float*)(p.ws + WS_GATES); const h16_t* y2 = (const h16_t*)(p.ws + WS_XN);
    unsigned* ctl = (unsigned*)(p.ws + WS_CTL);
    const int gw = bid * NAIVE_WAVES + wave, NGW = G * NAIVE_WAVES;
    float dmax = 0.f, dsum = 0.f, ymax = 0.f;
    for (int item = gw; item < M_ROWS * N_GROUPS; item += NGW) {
        const int g = item & 3, bt = item >> 2, b = bt >> 12, t = bt & (SEQ - 1);
        { const u32x2 a = *(const u32x2*)(qb + (size_t)bt * D_MODEL + g * 256 + 4 * lane), c = *(const u32x2*)(qrb + (size_t)bt * D_MODEL + g * 256 + 4 * lane);
          qs[4 * lane] = h_lo(a.x); qs[4 * lane + 1] = h_hi(a.x); qs[4 * lane + 2] = h_lo(a.y); qs[4 * lane + 3] = h_hi(a.y);
          qrs[4 * lane] = h_lo(c.x); qrs[4 * lane + 1] = h_hi(c.x); qrs[4 * lane + 2] = h_lo(c.y); qrs[4 * lane + 3] = h_hi(c.y); }
        const size_t bgoff = ((size_t)b * 4 + g) * SEQ * 64; const size_t strm = (size_t)16 * SEQ * 64;
        const h16_t* kcmp = (const h16_t*)(p.ws + WS_KCMP) + ((size_t)b * 4 + g) * 256 * 64; const h16_t* vcmp = (const h16_t*)(p.ws + WS_VCMP) + ((size_t)b * 4 + g) * 256 * 64;
        const h16_t* ks = kvb + 2 * strm + bgoff; const h16_t* vs = kvb + 3 * strm + bgoff; const h16_t* kw = kvb + 4 * strm + bgoff; const h16_t* vw = kvb + 5 * strm + bgoff;
        const int nv = t >= 31 ? ((t - 31) >> 4) + 1 : 0;
        for (int n = lane; n < 256; n += 64) {
            float a0 = -INFINITY, a1 = -INFINITY, a2 = -INFINITY, a3 = -INFINITY;
            if (n < nv) dot4(kcmp + (n >> 6) * 4096 + (n & 63) * 8, qs, a0, a1, a2, a3);
            pc[n] = a0; pc[256 + n] = a1; pc[512 + n] = a2; pc[768 + n] = a3;
        }
        float oc0 = 0.f, oc1 = 0.f, oc2 = 0.f, oc3 = 0.f;
        {
            const float i0 = softmax_row(pc, 256, lane), i1 = softmax_row(pc + 256, 256, lane), i2 = softmax_row(pc + 512, 256, lane), i3 = softmax_row(pc + 768, 256, lane);
            for (int n = lane; n < 256; n += 64) { pc[n] *= i0; pc[256 + n] *= i1; pc[512 + n] *= i2; pc[768 + n] *= i3; }
            for (int n = 0; n < nv; ++n) { const float v = h2f(vcmp[(n >> 6) * 4096 + vimg_off(n & 63, lane)]); oc0 += pc[n] * v; oc1 += pc[256 + n] * v; oc2 += pc[512 + n] * v; oc3 += pc[768 + n] * v; }
        }
        unsigned long long mask;
        {
            float imp = 0.f;
#pragma unroll
            for (int hh = 0; hh < 4; ++hh) {
                const LAS float* P = pc + hh * 256; const int j4 = 4 * lane;
                const float pm1 = (lane > 0) ? P[j4 - 1] : 0.f;
                imp += pm1 + 2.0f * (P[j4] + P[j4 + 1] + P[j4 + 2]) + P[j4 + 3];
            }
            const int cur = t >> 6; const bool valid = lane <= cur; const bool forced = (lane == 0) || (valid && lane > cur - 2);
            const float score = valid ? (forced ? 1e4f : imp) : -INFINITY;
            int rank = 0;
            for (int k = 0; k < 64; ++k) { const float sk = __shfl(score, k); rank += ((sk > score) || (sk == score && k < lane)) ? 1 : 0; }
            const bool selected = valid && rank < 16;
            mask = __ballot(selected);
            if (selected) sel[__popcll(mask & ((1ull << lane) - 1ull))] = lane;
        }
        int nsel = __popcll(mask); if (nsel > 16) nsel = 16;
        float os0 = 0.f, os1 = 0.f, os2 = 0.f, os3 = 0.f;
        {
            const int cnt = nsel * 64;
            for (int kk = lane; kk < cnt; kk += 64) {
                const int kpos = sel[kk >> 6] * 64 + (kk & 63);
                float a0 = -INFINITY, a1 = -INFINITY, a2 = -INFINITY, a3 = -INFINITY;
                if (kpos <= t) dot4(ks + (kpos >> 6) * 4096 + (kpos & 63) * 8, qrs, a0, a1, a2, a3);
                sc[kk] = a0; sc[1024 + kk] = a1; sc[2048 + kk] = a2; sc[3072 + kk] = a3;
            }
            const float i0 = softmax_row(sc, cnt, lane), i1 = softmax_row(sc + 1024, cnt, lane), i2 = softmax_row(sc + 2048, cnt, lane), i3 = softmax_row(sc + 3072, cnt, lane);
            for (int kk = 0; kk < cnt; ++kk) {
                const int kpos = sel[kk >> 6] * 64 + (kk & 63);
                const float v = h2f(vs[(kpos >> 6) * 4096 + vimg_off(kpos & 63, lane)]);
                os0 += sc[kk] * v; os1 += sc[1024 + kk] * v; os2 += sc[2048 + kk] * v; os3 += sc[3072 + kk] * v;
            }
            os0 *= i0; os1 *= i1; os2 *= i2; os3 *= i3;
        }
        float ow0 = 0.f, ow1 = 0.f, ow2 = 0.f, ow3 = 0.f;
        {
            const int nk = (t + 1 < 512) ? t + 1 : 512; const int k0 = t - nk + 1;
            for (int kk = lane; kk < nk; kk += 64) {
                const int kpos = k0 + kk;
                float a0, a1, a2, a3; dot4(kw + (kpos >> 6) * 4096 + (kpos & 63) * 8, qrs, a0, a1, a2, a3);
                sc[kk] = a0; sc[1024 + kk] = a1; sc[2048 + kk] = a2; sc[3072 + kk] = a3;
            }
            const float i0 = softmax_row(sc, nk, lane), i1 = softmax_row(sc + 1024, nk, lane), i2 = softmax_row(sc + 2048, nk, lane), i3 = softmax_row(sc + 3072, nk, lane);
            for (int kk = 0; kk < nk; ++kk) {
                const int kpos = k0 + kk;
                const float v = h2f(vw[(kpos >> 6) * 4096 + vimg_off(kpos & 63, lane)]);
                ow0 += sc[kk] * v; ow1 += sc[1024 + kk] * v; ow2 += sc[2048 + kk] * v; ow3 += sc[3072 + kk] * v;
            }
            ow0 *= i0; ow1 *= i1; ow2 *= i2; ow3 *= i3;
        }
        {
            const float* gr = gates + (size_t)bt * 48 + g * 12;
            const size_t o = (size_t)bt * D_MODEL + g * 256 + lane;
            const float r0 = (gr[0] * oc0 + gr[1] * os0 + gr[2] * ow0) * h2f(szb[o]);
            const float r1 = (gr[3] * oc1 + gr[4] * os1 + gr[5] * ow1) * h2f(szb[o + 64]);
            const float r2 = (gr[6] * oc2 + gr[7] * os2 + gr[8] * ow2) * h2f(szb[o + 128]);
            const float r3 = (gr[9] * oc3 + gr[10] * os3 + gr[11] * ow3) * h2f(szb[o + 192]);
            const float d0 = fabsf(r0 - h2f(y2[o])), d1 = fabsf(r1 - h2f(y2[o + 64])), d2 = fabsf(r2 - h2f(y2[o + 128])), d3 = fabsf(r3 - h2f(y2[o + 192]));
            dmax = fmaxf(dmax, fmaxf(fmaxf(d0, d1), fmaxf(d2, d3))); dsum += (d0 + d1) + (d2 + d3);
            ymax = fmaxf(ymax, fmaxf(fmaxf(fabsf(r0), fabsf(r1)), fmaxf(fabsf(r2), fabsf(r3))));
        }
    }
    dmax = wave_max(dmax); dsum = wave_sum(dsum); ymax = wave_max(ymax);
    if (!(dmax == dmax)) dmax = 1e30f;
    if (lane == 0) { atomicMax(&ctl[8300], __float_as_uint(dmax)); atomicAdd((float*)&ctl[8301], dsum); atomicMax(&ctl[8302], __float_as_uint(ymax)); }
}
__device__ __forceinline__ void phase_attn_report(const Params& p, int tid, int bid, int G) {
    unsigned* ctl = (unsigned*)(p.ws + WS_CTL); const int gt = bid * NTHREADS + tid, NGT = G * NTHREADS;
    const float dmax = __uint_as_float(ctl[8300]), dmean = __uint_as_float(ctl[8301]) / (float)(M_ROWS * 1024);
    if (gt == 0) p.out[0] = 100.0f + 1.0e6f * fminf(dmax, 1e20f);
    for (int i = 1024 + gt; i < 1024 + (1 << 20); i += NGT) p.out[i] = 100.0f * log2f(1.0f + 1.0e7f * dmean);
}
#endif

__device__ __forceinline__ void phase_final(const Params& p, int lane, int wave, int bid, int G) {
    const float* ss2 = (const float*)(p.ws + WS_SS2);
    const int gw = bid * NWAVES + wave, NGW = G * NWAVES;
    for (int m = gw; m < M_ROWS; m += NGW) {
        float s = (lane < 16) ? ss2[(size_t)m * 16 + lane] : 0.f; s = wave_sum(s);
        const float rs = rsqrtf(s * (1.0f / D_MODEL) + EPS);
        f32x4* xr = (f32x4*)(p.out + (size_t)m * D_MODEL) + lane; const f32x4* gr = (const f32x4*)p.final_norm + lane;
#pragma unroll
        for (int j = 0; j < 4; ++j) { const f32x4 v = xr[64 * j], g = gr[64 * j]; xr[64 * j] = v * rs * g; }
    }
}


#ifndef DIAG
#define DIAG 0
#endif
__device__ __forceinline__ void diag_scan_buf(const void* ptr, size_t n, bool is_fp16, int bufid, unsigned* ctl, int gt, int NGT) {
    unsigned bad = 0; float mx = 0.f;
    for (size_t i = gt; i < n; i += NGT) {
        float v = is_fp16 ? h2f(((const h16_t*)ptr)[i]) : ((const float*)ptr)[i];
        if (!(fabsf(v) < 3.0e38f)) bad++; else mx = fmaxf(mx, fabsf(v));
    }
    if (bad) atomicAdd(&ctl[8192 + bufid], bad);
    atomicMax(&ctl[8256 + bufid], __float_as_uint(mx));
}
__device__ __forceinline__ void phase_diag_scan(const Params& p, int tid, int bid, int G) {
    unsigned* ctl = (unsigned*)(p.ws + WS_CTL); const int gt = bid * NTHREADS + tid, NGT = G * NTHREADS; unsigned char* ws = p.ws;
    diag_scan_buf(ws + WS_Q, (size_t)M_ROWS * 1024, true, 0, ctl, gt, NGT);
    diag_scan_buf(ws + WS_QROT, (size_t)M_ROWS * 1024, true, 1, ctl, gt, NGT);
    diag_scan_buf(ws + WS_KV, (size_t)6 * 16 * SEQ * 64, true, 2, ctl, gt, NGT);
    diag_scan_buf(ws + WS_SZ, (size_t)M_ROWS * 1024, true, 3, ctl, gt, NGT);
    diag_scan_buf(ws + WS_KCMP, (size_t)16 * 256 * 64, true, 4, ctl, gt, NGT);
    diag_scan_buf(ws + WS_VCMP, (size_t)16 * 256 * 64, true, 5, ctl, gt, NGT);
    diag_scan_buf(ws + WS_GATES, (size_t)M_ROWS * 48, false, 6, ctl, gt, NGT);
    diag_scan_buf(ws + WS_SS1, (size_t)M_ROWS * 16, false, 7, ctl, gt, NGT);
    diag_scan_buf(ws + WS_ROPE, (size_t)SEQ * 16, false, 8, ctl, gt, NGT);
    diag_scan_buf(ws + WS_CBP, (size_t)2 * 32 * 256, false, 9, ctl, gt, NGT);
    diag_scan_buf(ws + WS_XN, (size_t)M_ROWS * 1024, true, 10, ctl, gt, NGT);
    diag_scan_buf(ws + WS_CW1K, (size_t)256 * 2048, true, 11, ctl, gt, NGT);
    diag_scan_buf(ws + WS_CW1V, (size_t)256 * 2048, true, 12, ctl, gt, NGT);
    diag_scan_buf(ws + WS_CW2K, (size_t)64 * 256, true, 13, ctl, gt, NGT);
    diag_scan_buf(ws + WS_CW2V, (size_t)64 * 256, true, 14, ctl, gt, NGT);
}
__device__ __forceinline__ void phase_diag_report(const Params& p, int tid, int bid, int G) {
    unsigned* ctl = (unsigned*)(p.ws + WS_CTL); const int gt = bid * NTHREADS + tid, NGT = G * NTHREADS;
    int first = -1; float mx = 0.f;
    for (int b = 14; b >= 0; --b) { if (ctl[8192 + b]) first = b; }
#if DIAG == 1
    for (int b = 0; b <= 14; ++b) mx = fmaxf(mx, __uint_as_float(ctl[8256 + b]));
#else
    for (int b = 11; b <= 14; ++b) mx = fmaxf(mx, __uint_as_float(ctl[8256 + b]));
#endif
    if (gt == 0) p.out[0] = 1.0e5f * (float)(2 + first);
    for (int i = 1024 + gt; i < 1024 + (1 << 20); i += NGT) p.out[i] = 100.0f * log2f(1.0f + mx);
}

__global__ void __launch_bounds__(NTHREADS, 2) yoco_fwd(Args args) {
    extern __shared__ __attribute__((aligned(16))) unsigned char lds_raw[];
    LAS unsigned char* lds = (LAS unsigned char*)lds_raw;
    const Params& p = args.p;
    const int tid = threadIdx.x, lane = tid & 63, wave = __builtin_amdgcn_readfirstlane(tid >> 6);
    const int G = gridDim.x, bid = blockIdx.x;
    unsigned char* ws = p.ws;
    for (int u = tid; u < (LDS_BYTES - LDSCTL_OFF) / 4; u += NTHREADS) ((LAS unsigned*)(lds + LDSCTL_OFF))[u] = 0u;
    __syncthreads();
    const int lo = args.ph_lo, hi = args.ph_hi;
    const bool multi = (hi - lo) > 1;
    XcdBarrier bar; bar.bar = (unsigned*)(ws + WS_CTL) + CW_BAR; bar.x = 0; bar.st = nullptr;
    if (multi) bar = xcd_barrier_post((unsigned*)(ws + WS_CTL) + CW_BAR, (volatile LAS unsigned*)(lds + LDSCTL_OFF) + 8);
#define IN(k) (lo <= (k) && (k) < hi)
#define SEAM(k) do { if (IN(k) && IN((k) + 1)) xcd_barrier(bar); } while (0)

    if (IN(0)) { phase_prologue(p, tid, lane, wave, bid, G); } SEAM(0);
    if (IN(1)) {
        pg8::Gemm g{(const h16_t*)(ws + WS_XN), (const h16_t*)(ws + WS_W1T), M_ROWS, 8192, 1024}; pg8::StaticOrder S; S.init(M_ROWS, 8192, G, bid);
        EpiGate E{(h16_t*)(ws + WS_CU), (h16_t*)(ws + WS_BSZ)};
        pg8::gemm_phase<EpiGate, pg8::StaticOrder, true, true>(lds, g, S, E);
    } SEAM(1);
    if (IN(2)) { phase_conv(p, tid, bid, G); } SEAM(2);
    if (IN(3)) {
        pg8::Gemm g{(const h16_t*)(ws + WS_BSZ), (const h16_t*)(ws + WS_W2T), M_ROWS, 1024, 2048}; pg8::StaticOrder S; S.init(M_ROWS, 1024, G, bid);
        EpiRes<true> E{p.x, p.out, (h16_t*)(ws + WS_XN), (float*)(ws + WS_SS1)};
        pg8::gemm_phase<EpiRes<true>, pg8::StaticOrder, true, true>(lds, g, S, E);
    } SEAM(3);
    if (IN(4)) {
        pg8::Gemm g{(const h16_t*)(ws + WS_XN), (const h16_t*)(ws + WS_W3T), M_ROWS, N3, 1024}; pg8::StaticOrder S; S.init(M_ROWS, N3, G, bid);
        EpiQKV E{(const float*)(ws + WS_SS1), (const float*)(ws + WS_ROPE), (h16_t*)(ws + WS_KV), (h16_t*)(ws + WS_Q), (h16_t*)(ws + WS_QROT), (h16_t*)(ws + WS_SZ), (float*)(ws + WS_GATES)};
        pg8::gemm_phase<EpiQKV, pg8::StaticOrder, true, true>(lds, g, S, E);
    } SEAM(4);
    if (IN(5)) { phase_compress(p, lds, lane, wave, bid, G); } SEAM(5);
#if DIAG
    if (IN(6)) { phase_diag_scan(p, tid, bid, G); } SEAM(6);
    if (IN(7)) { phase_diag_report(p, tid, bid, G); }
    if (IN(8)) { }
#else
    if (IN(6)) { fa::phase_attn(p, lds, tid, lane, wave, bid, G); } SEAM(6);
#if ATTN_DEBUG
    if (IN(9)) { phase_attn_naive(p, lds, lane, wave, bid, G); }
    if (IN(10)) { phase_attn_report(p, tid, bid, G); }
#endif
    if (IN(7)) {
        pg8::Gemm g{(const h16_t*)(ws + WS_XN), (const h16_t*)(ws + WS_W4T), M_ROWS, 1024, 1024}; pg8::StaticOrder S; S.init(M_ROWS, 1024, G, bid);
        EpiRes<false> E{p.out, p.out, nullptr, (float*)(ws + WS_SS2)};
        pg8::gemm_phase<EpiRes<false>, pg8::StaticOrder, true, true>(lds, g, S, E);
    } SEAM(7);
    if (IN(8)) { phase_final(p, lane, wave, bid, G); }
#endif
#undef IN
#undef SEAM
}

#ifndef N_LAUNCH_SPLIT
#define N_LAUNCH_SPLIT 0
#endif
extern "C" void kernel_launch(void* const* d_in, const int* in_sizes, int n_in, void* d_out, int out_size, void* d_ws, size_t ws_size, hipStream_t stream) {
    static int grid = 0;
    if (grid == 0) {
        if (n_in != 17 || out_size != M_ROWS * D_MODEL || ws_size < WS_END) { fprintf(stderr, "kernel_launch: unexpected shapes (n_in %d out %d ws %zu)\n", n_in, out_size, ws_size); grid = -1; return; }
        int dev = 0, cus = 0, per_cu = 0;
        if (hipGetDevice(&dev) != hipSuccess || hipDeviceGetAttribute(&cus, hipDeviceAttributeMultiprocessorCount, dev) != hipSuccess) { grid = -1; return; }
        if (hipFuncSetAttribute((const void*)yoco_fwd, hipFuncAttributeMaxDynamicSharedMemorySize, LDS_BYTES) != hipSuccess) { fprintf(stderr, "kernel_launch: hipFuncSetAttribute failed\n"); grid = -1; return; }
        if (hipOccupancyMaxActiveBlocksPerMultiprocessor(&per_cu, (const void*)yoco_fwd, NTHREADS, LDS_BYTES) != hipSuccess || per_cu < 1)
            fprintf(stderr, "kernel_launch: occupancy query reports %d\n", per_cu);
        (void)hipGetLastError();
        grid = cus;
    }
    if (grid < 0) return;
    (void)hipMemsetAsync((char*)d_ws + WS_CTL, 0, CTL_ZERO_BYTES, stream);
    Args a{};
    const float** pp = (const float**)&a.p;
    for (int i = 0; i < 17; ++i) pp[i] = (const float*)d_in[i];
    a.p.out = (float*)d_out; a.p.ws = (unsigned char*)d_ws;
#if ATTN_DEBUG
    { const int seq[9] = {0, 1, 2, 3, 4, 5, 6, 9, 10};
      for (int k = 0; k < 9; ++k) { a.ph_lo = seq[k]; a.ph_hi = seq[k] + 1; hipLaunchKernelGGL(yoco_fwd, dim3(grid), dim3(NTHREADS), LDS_BYTES, stream, a); } }
#elif N_LAUNCH_SPLIT
#ifndef PH_MAX
#define PH_MAX N_PHASES
#endif
    for (int ph = 0; ph < PH_MAX; ++ph) { a.ph_lo = ph; a.ph_hi = ph + 1; hipLaunchKernelGGL(yoco_fwd, dim3(grid), dim3(NTHREADS), LDS_BYTES, stream, a); }
#else
    a.ph_lo = 0; a.ph_hi = N_PHASES; hipLaunchKernelGGL(yoco_fwd, dim3(grid), dim3(NTHREADS), LDS_BYTES, stream, a);
#endif
}
```
